# Optimizing an MI355X kernel written in HIP

```python
import jax, jax.numpy as jnp
from jax import lax
import numpy as np

D_MODEL = 1024
BATCH = 16
SEQ = 4096
DEPTH = 4

CHUNK = 64
N_MEM = 256
N_GROUPS = 4
GROUP = D_MODEL // N_GROUPS
RET_HEADS = 4
RET_HD = GROUP // RET_HEADS
ROPE_BASE = 10000.0
LRU_WIDTH = GROUP
LRU_BLOCKS = 4
LRU_BD = LRU_WIDTH // LRU_BLOCKS
CONV_W = 4
LRU_C = 8.0
GLA_HEADS = 4
GLA_DK = GROUP // 2
GLA_DV = GROUP
GLA_RANK = 16
GLA_TAU = 16.0
HGRN_HEADS = 4
HGRN_HD = GROUP // HGRN_HEADS
XA_HEADS = 4
XA_HD = D_MODEL // XA_HEADS
D_FF = 2816
EPS = 1e-6
IN_SPLITS = (GROUP, GROUP, GROUP, GROUP,
             LRU_WIDTH, LRU_WIDTH,
             GLA_DK, GLA_DK, GLA_DV, GLA_RANK, GLA_DV,
             GROUP, GROUP, GROUP, GROUP)
D_IN = 8 * GROUP + 2 * LRU_WIDTH + 2 * GLA_DK + 2 * GLA_DV + GLA_RANK

kernel_name = "hybrid_chunk_causal_parallel_groups"


def rms_norm(x, g):
    xf = x.astype(jnp.float32)
    y = xf * lax.rsqrt(jnp.mean(xf * xf, axis=-1, keepdims=True) + EPS)
    return (y * g.astype(jnp.float32)).astype(x.dtype)


def head_norm(o):
    of = o.astype(jnp.float32)
    mu = jnp.mean(of, axis=-1, keepdims=True)
    var = jnp.mean(jnp.square(of - mu), axis=-1, keepdims=True)
    return ((of - mu) * lax.rsqrt(var + EPS)).astype(o.dtype)


def swiglu(x, w_gu, w_down):
    g, u = jnp.split(x @ w_gu, 2, axis=-1)
    return (jax.nn.silu(g) * u) @ w_down


def to_heads(t, n_heads):
    b, s, _ = t.shape
    return t.reshape(b, s, n_heads, -1).transpose(0, 2, 1, 3)


def from_heads(t):
    b, h, s, d = t.shape
    return t.transpose(0, 2, 1, 3).reshape(b, s, h * d)


def rope(t, cos, sin):
    t1, t2 = jnp.split(t, 2, axis=-1)
    return jnp.concatenate([t1 * cos - t2 * sin, t1 * sin + t2 * cos], axis=-1)


def chunk_gated_linear_attn(q, k, v, log_f, causal_in_chunk):
    b_, h_, s_, dk = q.shape
    dv = v.shape[-1]
    nc = s_ // CHUNK

    def to_chunks(t):
        return jnp.moveaxis(t.reshape(b_, h_, nc, CHUNK, t.shape[-1]), 2, 0)

    pos = jnp.arange(CHUNK)
    if causal_in_chunk:
        mask = pos[:, None] >= pos[None, :]
    else:
        mask = jnp.ones((CHUNK, CHUNK), dtype=bool)

    def step(state, inp):
        qc, kc, vc, gc = (t.astype(jnp.float32) for t in inp)
        cum = jnp.cumsum(gc, axis=2)
        decay = jnp.exp(-jnp.abs(cum[:, :, :, None, :] - cum[:, :, None, :, :]))
        decay = jnp.where(mask[None, None, :, :, None], decay, 0.0)
        scores = jnp.einsum("bhjd,bhmd,bhjmd->bhjm", qc, kc, decay)
        out = (jnp.einsum("bhjm,bhme->bhje", scores, vc)
               + jnp.einsum("bhjd,bhde->bhje", qc * jnp.exp(cum), state))
        last = cum[:, :, -1, :]
        state = (jnp.exp(last)[..., None] * state
                 + jnp.einsum("bhmd,bhme->bhde", kc * jnp.exp(last[:, :, None, :] - cum), vc))
        return state, out

    state0 = jnp.zeros((b_, h_, dk, dv), jnp.float32)
    _, out = lax.scan(step, state0, (to_chunks(q), to_chunks(k), to_chunks(v), to_chunks(log_f)))
    return jnp.moveaxis(out, 0, 2).reshape(b_, h_, s_, dv).astype(v.dtype)


def retention_group(q, k, v, g, cos, sin):
    qh = rope(to_heads(q, RET_HEADS), cos, sin)
    kh = rope(to_heads(k, RET_HEADS), cos, sin) * (RET_HD ** -0.5)
    vh = to_heads(v, RET_HEADS)
    log_gamma = jnp.log1p(-jnp.exp2(-5.0 - jnp.arange(RET_HEADS, dtype=jnp.float32)))
    log_f = jnp.broadcast_to(log_gamma[None, :, None, None], qh.shape)
    o = chunk_gated_linear_attn(qh, kh, vh, log_f, causal_in_chunk=False)
    return jax.nn.silu(g) * from_heads(head_norm(o))


def rglru_group(xb, gate, conv_w, conv_b, wa, ba, wx, bx, lam):
    b_, s_, w_ = xb.shape
    xc = lax.conv_general_dilated(xb, conv_w[:, None, :], window_strides=(1,),
                                  padding=[(CONV_W - 1, 0)],
                                  dimension_numbers=("NWC", "WIO", "NWC"),
                                  feature_group_count=w_) + conv_b
    xblk = xc.reshape(b_, s_, LRU_BLOCKS, LRU_BD)
    r = jax.nn.sigmoid(jnp.einsum("bsnd,nde->bsne", xblk, wa).reshape(b_, s_, w_) + ba)
    i = jax.nn.sigmoid(jnp.einsum("bsnd,nde->bsne", xblk, wx).reshape(b_, s_, w_) + bx)
    log_a = (LRU_C * r.astype(jnp.float32)) * jax.nn.log_sigmoid(lam.astype(jnp.float32))
    a = jnp.exp(log_a)
    u = jnp.sqrt(-jnp.expm1(2.0 * log_a)) * (i * xc).astype(jnp.float32)

    def combine(left, right):
        a1, b1 = left
        a2, b2 = right
        return a1 * a2, a2 * b1 + b2

    _, h = lax.associative_scan(combine, (a, u), axis=1)
    return h.astype(xb.dtype) * jax.nn.gelu(gate)


def gla_group(q, k, v, a_lr, g, w_a2, b_a):
    qh = to_heads(q, GLA_HEADS) * ((GLA_DK // GLA_HEADS) ** -0.5)
    kh = to_heads(k, GLA_HEADS)
    vh = to_heads(v, GLA_HEADS)
    a_pre = (a_lr @ w_a2 + b_a).astype(jnp.float32)
    log_f = to_heads(jax.nn.log_sigmoid(a_pre) / GLA_TAU, GLA_HEADS)
    o = chunk_gated_linear_attn(qh, kh, vh, log_f, causal_in_chunk=False)
    return jax.nn.silu(g) * from_heads(head_norm(o))


def hgrn2_group(q, f_pre, i, g, lb):
    fp = f_pre.astype(jnp.float32)
    lbf = lb.astype(jnp.float32)
    log_f = jnp.logaddexp(jnp.log(lbf), jnp.log1p(-lbf) + jax.nn.log_sigmoid(fp))
    k = ((1.0 - lbf) * jax.nn.sigmoid(-fp)).astype(q.dtype)
    qh = to_heads(jax.nn.silu(q), HGRN_HEADS)
    o = chunk_gated_linear_attn(qh, to_heads(k, HGRN_HEADS), to_heads(i, HGRN_HEADS),
                                to_heads(log_f, HGRN_HEADS), causal_in_chunk=True)
    return jax.nn.silu(g) * from_heads(head_norm(o))


def cross_attention(h, m, wq, wkv, wo):
    qh = to_heads(h @ wq, XA_HEADS)
    k, v = jnp.split(m @ wkv, 2, axis=-1)
    kh = to_heads(k, XA_HEADS)
    vh = to_heads(v, XA_HEADS)
    s = jnp.einsum("bhqd,bhkd->bhqk", qh, kh).astype(jnp.float32) * (XA_HD ** -0.5)
    p = jax.nn.softmax(s, axis=-1).astype(vh.dtype)
    return from_heads(jnp.einsum("bhqk,bhkd->bhqd", p, vh)) @ wo


def setup_inputs(seed: int = 0) -> dict:
    key = jax.random.key(seed)
    ks = iter(jax.random.split(key, 64))
    L = DEPTH

    def nrm(shape, fan_in):
        return jax.random.normal(next(ks), shape, jnp.float32) * (fan_in ** -0.5)

    def gain(shape):
        return 1.0 + 0.02 * jax.random.normal(next(ks), shape, jnp.float32)

    def small(shape):
        return 0.01 * jax.random.normal(next(ks), shape, jnp.float32)

    x = jax.random.normal(next(ks), (BATCH, SEQ, D_MODEL), jnp.float32)
    mem = jax.random.normal(next(ks), (BATCH, N_MEM, D_MODEL), jnp.float32)
    u = jax.random.uniform(next(ks), (L, LRU_WIDTH), jnp.float32, minval=0.9, maxval=0.999)
    s = u ** (1.0 / LRU_C)
    lru_lambda = jnp.log(s) - jnp.log1p(-s)
    return {
        "x": x,
        "mem": mem,
        "ffn1_norm": gain((L, D_MODEL)),
        "ffn1_w_gu": nrm((L, D_MODEL, 2 * D_FF), D_MODEL),
        "ffn1_w_down": nrm((L, D_FF, D_MODEL), D_FF),
        "mix_norm": gain((L, D_MODEL)),
        "w_in": nrm((L, D_MODEL, D_IN), D_MODEL),
        "w_out": nrm((L, N_GROUPS * GROUP, D_MODEL), N_GROUPS * GROUP),
        "lru_conv_w": nrm((L, CONV_W, LRU_WIDTH), CONV_W),
        "lru_conv_b": small((L, LRU_WIDTH)),
        "lru_wa": nrm((L, LRU_BLOCKS, LRU_BD, LRU_BD), LRU_BD),
        "lru_ba": small((L, LRU_WIDTH)),
        "lru_wx": nrm((L, LRU_BLOCKS, LRU_BD, LRU_BD), LRU_BD),
        "lru_bx": small((L, LRU_WIDTH)),
        "lru_lambda": lru_lambda,
        "gla_w_a2": nrm((L, GLA_RANK, GLA_DK), GLA_RANK),
        "gla_b_a": small((L, GLA_DK)),
        "hgrn_lb_logits": 0.1 * jax.random.normal(next(ks), (L, GROUP), jnp.float32),
        "xattn_norm": gain((L, D_MODEL)),
        "mem_norm": gain((L, D_MODEL)),
        "xattn_wq": nrm((L, D_MODEL, D_MODEL), D_MODEL),
        "xattn_wkv": nrm((L, D_MODEL, 2 * D_MODEL), D_MODEL),
        "xattn_wo": nrm((L, D_MODEL, D_MODEL), D_MODEL),
        "ffn2_norm": gain((L, D_MODEL)),
        "ffn2_w_gu": nrm((L, D_MODEL, 2 * D_FF), D_MODEL),
        "ffn2_w_down": nrm((L, D_FF, D_MODEL), D_FF),
        "final_norm": gain((D_MODEL,)),
    }


def reference(x, mem, ffn1_norm, ffn1_w_gu, ffn1_w_down, mix_norm, w_in, w_out,
              lru_conv_w, lru_conv_b, lru_wa, lru_ba, lru_wx, lru_bx, lru_lambda,
              gla_w_a2, gla_b_a, hgrn_lb_logits, xattn_norm, mem_norm,
              xattn_wq, xattn_wkv, xattn_wo, ffn2_norm, ffn2_w_gu, ffn2_w_down, final_norm):
    seq = x.shape[1]
    inv_freq = ROPE_BASE ** (-jnp.arange(RET_HD // 2, dtype=jnp.float32) / (RET_HD // 2))
    ang = jnp.arange(seq, dtype=jnp.float32)[:, None] * inv_freq[None, :]
    cos = jnp.cos(ang).astype(x.dtype)
    sin = jnp.sin(ang).astype(x.dtype)
    lb_cum = jnp.cumsum(jax.nn.softmax(hgrn_lb_logits.astype(jnp.float32), axis=0), axis=0)
    lb_all = lb_cum - lb_cum[0:1]
    split_at = [int(c) for c in np.cumsum(IN_SPLITS)[:-1]]

    for l in range(DEPTH):
        x = x + 0.5 * swiglu(rms_norm(x, ffn1_norm[l]), ffn1_w_gu[l], ffn1_w_down[l])
        h = rms_norm(x, mix_norm[l])
        (rq, rk, rv, rg, lx, lg, gq, gk, gv, ga, gg, hq, hf, hi, hg) = jnp.split(h @ w_in[l], split_at, axis=-1)
        y = jnp.concatenate([
            retention_group(rq, rk, rv, rg, cos, sin),
            rglru_group(lx, lg, lru_conv_w[l], lru_conv_b[l], lru_wa[l], lru_ba[l],
                        lru_wx[l], lru_bx[l], lru_lambda[l]),
            gla_group(gq, gk, gv, ga, gg, gla_w_a2[l], gla_b_a[l]),
            hgrn2_group(hq, hf, hi, hg, lb_all[l]),
        ], axis=-1)
        x = x + y @ w_out[l]
        x = x + cross_attention(rms_norm(x, xattn_norm[l]), rms_norm(mem, mem_norm[l]),
                                xattn_wq[l], xattn_wkv[l], xattn_wo[l])
        x = x + 0.5 * swiglu(rms_norm(x, ffn2_norm[l]), ffn2_w_gu[l], ffn2_w_down[l])
    return rms_norm(x, final_norm)
```

```cpp
#include <hip/hip_runtime.h>
#include <hip/hip_cooperative_groups.h>
#include <cstdio>
#include <cstdint>
#include <cmath>
namespace cg = cooperative_groups;

#ifndef MK_ONE_LAUNCH
#define MK_ONE_LAUNCH 1
#endif

#define LAS __attribute__((address_space(3)))
typedef unsigned short bf16_t;
typedef short bf16x8 __attribute__((ext_vector_type(8)));
typedef float f32x4 __attribute__((ext_vector_type(4)));
typedef unsigned u32x4 __attribute__((ext_vector_type(4)));
typedef unsigned u32x2 __attribute__((ext_vector_type(2)));

constexpr int TT = 65536, DM = 1024, FF = 2816, DIN = 3344, DINP = 3584, NL = 4, SEQ = 4096;
constexpr float EPS = 1e-6f;
constexpr size_t MiB = 1u << 20;
constexpr size_t WS_ROPE = 1 * MiB;
constexpr size_t WS_W = 2 * MiB, LAYER_W = 50 * MiB;
constexpr size_t W_GU1 = 0, W_D1 = 11 * MiB, W_IN = W_D1 + 5632 * 1024, W_OUT = W_IN + 7 * MiB, W_Q = W_OUT + 2 * MiB, W_KV = W_Q + 2 * MiB,
                 W_O = W_KV + 4 * MiB, W_GU2 = W_O + 2 * MiB, W_D2 = W_GU2 + 11 * MiB;
static_assert(W_D2 + 5632 * 1024 == LAYER_W, "weight map");
constexpr size_t WS_MEMN = 202 * MiB;
constexpr size_t WS_KV = 234 * MiB;
constexpr size_t WS_HN = 298 * MiB;
constexpr size_t WS_PROJ = 426 * MiB;
constexpr size_t WS_XM = WS_PROJ + 128 * MiB;
constexpr size_t WS_XN = WS_PROJ + 160 * MiB;
constexpr size_t WS_END = 874 * MiB;

struct Params {
    const float* in[27];
    float* out; unsigned char* ws;
    float inv_freq[32];
    int lo, hi;
};


constexpr int LDS_BYTES = 147456;
constexpr int PARAM_OFF = LDS_BYTES - 1024;
struct Ctx {
    LAS unsigned char* lds;
    __device__ __forceinline__ unsigned long long q(int i) const { const LAS unsigned* pw = (const LAS unsigned*)(lds + PARAM_OFF) + 2 * i;
        const unsigned lo = __builtin_amdgcn_readfirstlane(pw[0]), hi = __builtin_amdgcn_readfirstlane(pw[1]); return ((unsigned long long)hi << 32) | lo; }
    __device__ __forceinline__ const float* in(int i) const { return (const float*)q(i); }
    __device__ __forceinline__ float* out() const { return (float*)q(27); }
    __device__ __forceinline__ unsigned char* ws() const { return (unsigned char*)q(28); }
    __device__ __forceinline__ float invf(int d) const { return ((const LAS float*)(lds + PARAM_OFF))[58 + d]; }
    __device__ __forceinline__ int lo() const { return __builtin_amdgcn_readfirstlane(((const LAS int*)(lds + PARAM_OFF))[90]); }
    __device__ __forceinline__ int hi() const { return __builtin_amdgcn_readfirstlane(((const LAS int*)(lds + PARAM_OFF))[91]); }
};
static_assert(sizeof(Params) == 368, "Params layout");

__device__ __forceinline__ int opaque_tid() { int t = threadIdx.x; asm volatile("" : "+v"(t)); return t; }
__device__ __forceinline__ unsigned f2bf(float f) { unsigned u = __float_as_uint(f); return (u + 0x7fffu + ((u >> 16) & 1u)) >> 16; }
__device__ __forceinline__ unsigned pk2(float lo, float hi) { return f2bf(lo) | (f2bf(hi) << 16); }
__device__ __forceinline__ float bflo(unsigned w) { return __uint_as_float(w << 16); }
__device__ __forceinline__ float bfhi(unsigned w) { return __uint_as_float(w & 0xffff0000u); }
__device__ __forceinline__ float sigmoidf_(float x) { return 1.0f / (1.0f + __expf(-x)); }
__device__ __forceinline__ float siluf_(float x) { return x / (1.0f + __expf(-x)); }
__device__ __forceinline__ float wave_sum(float v) {
#pragma unroll
    for (int o = 1; o < 64; o <<= 1) v += __shfl_xor(v, o);
    return v;
}

namespace pg8 {
constexpr int BM = 256, BK = 64, HALF = 128, HTB = HALF * BK * 2, STAGE_BYTES = 8 * HTB, NXCD = 8, WGM = 8;
__host__ __device__ __forceinline__ int lds_byte(int r, int c) { const int st = (r >> 4) * 2 + (c >> 5), rr = r & 15, cc = c & 31, ob = rr * 64 + cc * 2; return st * 1024 + (ob ^ (((ob >> 9) & 1) << 5)); }
__host__ __device__ __forceinline__ void stage_rc(int b, int& R, int& C) { const int st = b / 1024, sb = b % 1024, swz = sb ^ (((sb >> 9) & 1) << 5); R = (st >> 1) * 16 + swz / 64; C = (st & 1) * 32 + (swz % 64) / 2; }
__host__ __device__ __forceinline__ int perm32(int rho) { const int n = rho >> 4, i = rho & 15; return 8 * (i >> 2) + 4 * n + (i & 3); }

struct Unit { size_t offA, offB, offC; };
struct Gemm { const char* A; const char* Bt; int lda, ldb, K; };

struct Sched {
    int kind, nM, nN, nwg, G, c, ldc, cw;
    size_t tA, tB, bB;
    __device__ __forceinline__ bool next(int i, Unit& u) const {
        const long L = (long)i * G + c; if (L >= nwg) return false;
        if (kind <= 1) {
            int wgid = (int)L; { const int q = nwg / NXCD, r = nwg % NXCD, xcd = wgid % NXCD, off = wgid / NXCD; wgid = (xcd < r ? xcd * (q + 1) : r * (q + 1) + (xcd - r) * q) + off; }
            const int nig = WGM * nN, gid = wgid / nig, fm = gid * WGM, gsz = (nM - fm) < WGM ? (nM - fm) : WGM;
            const int pm = fm + ((wgid % nig) % gsz), pn = (wgid % nig) / gsz;
            u.offA = (size_t)pm * tA; u.offB = (size_t)pn * tB + (kind == 1 ? (size_t)(pm >> 4) * bB : (size_t)0); u.offC = (size_t)pm * 256 * ldc + (size_t)pn * cw;
        } else if (kind == 2) {
            const int ll = (int)L >> 7, r = (int)L & 127, pm = r >> 3, pn = r & 7;
            u.offA = (size_t)ll * (4096 * 1024 * 2) + (size_t)pm * tA; u.offB = (size_t)ll * LAYER_W + (size_t)pn * tB; u.offC = (size_t)ll * (4096 * 2048) + (size_t)pm * 256 * 2048 + (size_t)pn * 256;
        } else if (kind == 3) {
            const int z = (int)L >> 2, pn = (int)L & 3, b = z >> 2, h = z & 3;
            u.offA = ((size_t)(b * 256) * 2048 + h * 256) * 2; u.offB = ((size_t)pn * 256 * 1024 + h * 256) * 2; u.offC = (size_t)b * 1024 * 1024 + (size_t)(h * 256) * 1024 + pn * 256;
        } else {
            const int z = (int)L >> 2, pm = (int)L & 3, b = z >> 2, h = z & 3;
            u.offA = ((size_t)pm * 256 * 1024 + h * 256) * 2; u.offB = ((size_t)(b * 256) * 2048 + 1024 + h * 256) * 2; u.offC = (size_t)b * 1024 * 1024 + (size_t)(pm * 256) * 1024 + h * 256;
        }
        return true;
    }
};

__device__ __forceinline__ unsigned cvt_pk_bf16(float lo, float hi) { unsigned r; asm volatile("v_cvt_pk_bf16_f32 %0, %1, %2" : "=v"(r) : "v"(lo), "v"(hi)); return r; }

struct EpiBf16 {
    static constexpr bool PERM = true;
    bf16_t* O; int ldc; float sc;
    __device__ __forceinline__ void operator()(const f32x4 (&acc)[2][2][4][2], const Unit& u, int wr, int wc, int fr, int fq) const {
        bf16_t* base = O + u.offC + (size_t)(wr * 64 + fr) * ldc + wc * 32 + 8 * fq;
#pragma unroll
        for (int ai = 0; ai < 2; ++ai)
#pragma unroll
            for (int m = 0; m < 4; ++m) { bf16_t* rowp = base + (size_t)(ai * HALF + m * 16) * ldc;
#pragma unroll
                for (int bj = 0; bj < 2; ++bj) { const f32x4 v0 = acc[ai][bj][m][0] * sc, v1 = acc[ai][bj][m][1] * sc;
                    u32x4 w; w.x = cvt_pk_bf16(v0[0], v0[1]); w.y = cvt_pk_bf16(v0[2], v0[3]); w.z = cvt_pk_bf16(v1[0], v1[1]); w.w = cvt_pk_bf16(v1[2], v1[3]);
                    *(u32x4*)(rowp + bj * HALF) = w; } }
    }
};
struct EpiSwi {
    static constexpr bool PERM = true;
    bf16_t* O; int ldc;
    __device__ __forceinline__ void operator()(const f32x4 (&acc)[2][2][4][2], const Unit& u, int wr, int wc, int fr, int fq) const {
        bf16_t* base = O + u.offC + (size_t)(wr * 64 + fr) * ldc + wc * 32 + 8 * fq;
#pragma unroll
        for (int ai = 0; ai < 2; ++ai)
#pragma unroll
            for (int m = 0; m < 4; ++m) { bf16_t* rowp = base + (size_t)(ai * HALF + m * 16) * ldc;
                float r[8];
#pragma unroll
                for (int n = 0; n < 2; ++n)
#pragma unroll
                    for (int e = 0; e < 4; ++e) { const float g = acc[ai][0][m][n][e], up = acc[ai][1][m][n][e]; r[n * 4 + e] = g * __builtin_amdgcn_rcpf(1.0f + __expf(-g)) * up; }
                u32x4 w; w.x = cvt_pk_bf16(r[0], r[1]); w.y = cvt_pk_bf16(r[2], r[3]); w.z = cvt_pk_bf16(r[4], r[5]); w.w = cvt_pk_bf16(r[6], r[7]);
                *(u32x4*)rowp = w; }
    }
};
struct EpiRes {
    static constexpr bool PERM = false;
    float* X; float sc;
    __device__ __forceinline__ void operator()(const f32x4 (&acc)[2][2][4][2], const Unit& u, int wr, int wc, int fr, int fq) const {
        float* base = X + u.offC + (size_t)(wr * 64 + fr) * 1024 + wc * 32 + 4 * fq;
#pragma unroll
        for (int ai = 0; ai < 2; ++ai)
#pragma unroll
            for (int m = 0; m < 4; ++m) { float* rowp = base + (size_t)(ai * HALF + m * 16) * 1024;
#pragma unroll
                for (int bj = 0; bj < 2; ++bj)
#pragma unroll
                    for (int n = 0; n < 2; ++n) { f32x4* q = (f32x4*)(rowp + bj * HALF + n * 16); *q = *q + acc[ai][bj][m][n] * sc; } }
    }
};

template <class Epi>
__device__ __forceinline__ void gemm_phase(LAS unsigned char* lds, const Gemm g, const Sched& S, const Epi& E) {
    const int tid = opaque_tid(), wid = __builtin_amdgcn_readfirstlane(tid >> 6), lane = tid & 63, wr = wid >> 2, wc = wid & 3, fr = lane & 15, fq = lane >> 4;
    const int K = g.K, nt = K / BK;
    unsigned voffA[2], voffB[2];
#pragma unroll
    for (int i = 0; i < 2; ++i) { int R, C; stage_rc(tid * 16 + i * 8192, R, C); const int Rb = Epi::PERM ? ((R & ~31) + perm32(R & 31)) : R;
        voffA[i] = (unsigned)(R * g.lda + C) * 2u; voffB[i] = (unsigned)(Rb * g.ldb + C) * 2u; }
    const size_t kstep = (size_t)(BK * 2);
    const size_t hstepA = (size_t)HALF * g.lda * 2, hstepB = (size_t)HALF * g.ldb * 2;
    const unsigned ldsw = (unsigned)wid * 1024u;
    const int aoff = lds_byte(wr * 64 + fr, fq * 8), boff = lds_byte(wc * 32 + fr, fq * 8);
#define PG8_SA(b, h) (((b) * 2 + (h)) * HTB)
#define PG8_SB(b, h) ((4 + (b) * 2 + (h)) * HTB)
#define PG8_STAGE(bufoff, gbase, voff) do { _Pragma("unroll") for (int _i = 0; _i < 2; ++_i) \
        __builtin_amdgcn_global_load_lds((const unsigned*)((const char*)(gbase) + (voff)[_i]), (LAS unsigned*)(lds + (bufoff) + ldsw + _i * 8192), 16, 0, 0); } while (0)
#define PG8_LDA(dst, b, h) do { _Pragma("unroll") for (int m = 0; m < 4; ++m) _Pragma("unroll") for (int k = 0; k < 2; ++k) dst[m][k] = *(const LAS bf16x8*)(lds + PG8_SA(b, h) + aoff + m * 2048 + k * 1024); } while (0)
#define PG8_LDB(dst, b, h) do { _Pragma("unroll") for (int n = 0; n < 2; ++n) _Pragma("unroll") for (int k = 0; k < 2; ++k) dst[n][k] = *(const LAS bf16x8*)(lds + PG8_SB(b, h) + boff + n * 2048 + k * 1024); } while (0)
#define PG8_MMA(ai, bj, At, Bt) do { __builtin_amdgcn_s_setprio(1); _Pragma("unroll") for (int m = 0; m < 4; ++m) _Pragma("unroll") for (int n = 0; n < 2; ++n) _Pragma("unroll") for (int k = 0; k < 2; ++k) \
        acc[ai][bj][m][n] = __builtin_amdgcn_mfma_f32_16x16x32_bf16(Bt[n][k], At[m][k], acc[ai][bj][m][n], 0, 0, 0); __builtin_amdgcn_s_setprio(0); } while (0)
#define PG8_WAIT_V(n) asm volatile("s_waitcnt vmcnt(" #n ")" ::: "memory")
#define PG8_WAIT_L(n) asm volatile("s_waitcnt lgkmcnt(" #n ")" ::: "memory")
#define PG8_BAR __builtin_amdgcn_s_barrier()
#define PG8_SCHED __builtin_amdgcn_sched_barrier(0)
    Unit cur, nxt; int ui = 0;
    if (!S.next(0, cur)) return;
    f32x4 acc[2][2][4][2];
#pragma unroll
    for (int a = 0; a < 2; ++a)
#pragma unroll
        for (int b = 0; b < 2; ++b)
#pragma unroll
            for (int m = 0; m < 4; ++m)
#pragma unroll
                for (int n = 0; n < 2; ++n) acc[a][b][m][n] = (f32x4){0.f, 0.f, 0.f, 0.f};
    bf16x8 At[4][2], B0[2][2], B1[2][2];
    const char* cA = g.A + cur.offA; const char* cB = g.Bt + cur.offB;
    PG8_STAGE(PG8_SB(0, 0), cB, voffB); PG8_STAGE(PG8_SB(0, 1), cB + hstepB, voffB); PG8_STAGE(PG8_SA(0, 0), cA, voffA); PG8_STAGE(PG8_SA(0, 1), cA + hstepA, voffA);
    if (wr == 1) PG8_BAR;
    PG8_WAIT_V(2); PG8_BAR;
    PG8_STAGE(PG8_SB(1, 0), cB + kstep, voffB); PG8_STAGE(PG8_SA(1, 0), cA + kstep, voffA); PG8_STAGE(PG8_SB(1, 1), cB + hstepB + kstep, voffB);
    PG8_WAIT_V(6); PG8_BAR;
    for (;;) {
        const bool has_next = S.next(ui + 1, nxt);
        const char* nA = has_next ? g.A + nxt.offA : cA; const char* nB = has_next ? g.Bt + nxt.offB : cB;
        for (int t = 0; t < nt; t += 2) {
            const bool last = (t == nt - 2);
            const char* a1 = cA + (size_t)(t + 1) * kstep;
            const char* a2 = last ? nA : cA + (size_t)(t + 2) * kstep; const char* b2 = last ? nB : cB + (size_t)(t + 2) * kstep;
            const char* a3 = a2 + kstep; const char* b3 = b2 + kstep;
            PG8_LDB(B0, 0, 0); PG8_LDB(B1, 0, 1); PG8_SCHED; PG8_LDA(At, 0, 0); PG8_STAGE(PG8_SA(1, 1), a1 + hstepA, voffA);
            PG8_WAIT_V(8); PG8_WAIT_L(0); PG8_BAR; PG8_MMA(0, 0, At, B0); PG8_MMA(0, 1, At, B1); PG8_BAR; PG8_SCHED;
            PG8_LDA(At, 0, 1); PG8_STAGE(PG8_SB(0, 0), b2, voffB); PG8_STAGE(PG8_SB(0, 1), b2 + hstepB, voffB); PG8_STAGE(PG8_SA(0, 0), a2, voffA);
            PG8_WAIT_V(8); PG8_WAIT_L(0); PG8_BAR; PG8_MMA(1, 0, At, B0); PG8_MMA(1, 1, At, B1); PG8_BAR; PG8_SCHED;
            PG8_LDB(B0, 1, 0); PG8_LDB(B1, 1, 1); PG8_SCHED; PG8_LDA(At, 1, 0); PG8_STAGE(PG8_SA(0, 1), a2 + hstepA, voffA);
            PG8_WAIT_V(8); PG8_WAIT_L(0); PG8_BAR; PG8_MMA(0, 0, At, B0); PG8_MMA(0, 1, At, B1); PG8_BAR; PG8_SCHED;
            PG8_LDA(At, 1, 1); PG8_STAGE(PG8_SB(1, 0), b3, voffB); PG8_STAGE(PG8_SB(1, 1), b3 + hstepB, voffB); PG8_STAGE(PG8_SA(1, 0), a3, voffA);
            PG8_WAIT_V(8); PG8_WAIT_L(0); PG8_BAR; PG8_MMA(1, 0, At, B0); PG8_MMA(1, 1, At, B1); PG8_BAR; PG8_SCHED;
        }
        if (wr == 0) PG8_BAR;
        E(acc, cur, wr, wc, fr, fq);
        if (!has_next) break;
#pragma unroll
        for (int a = 0; a < 2; ++a)
#pragma unroll
            for (int b = 0; b < 2; ++b)
#pragma unroll
                for (int m = 0; m < 4; ++m)
#pragma unroll
                    for (int n = 0; n < 2; ++n) acc[a][b][m][n] = (f32x4){0.f, 0.f, 0.f, 0.f};
        cur = nxt; cA = nA; cB = nB; ++ui;
        if (wr == 1) PG8_BAR;
    }
    PG8_WAIT_V(0);
    PG8_BAR;
#undef PG8_SA
#undef PG8_SB
#undef PG8_STAGE
#undef PG8_LDA
#undef PG8_LDB
#undef PG8_MMA
#undef PG8_WAIT_V
#undef PG8_WAIT_L
#undef PG8_BAR
#undef PG8_SCHED
}
}

__device__ __forceinline__ void transpose_item(const float* W, int K, int N, bf16_t* WT, int out_row0, int k0, int n0, LAS float* scr, int lane) {
    const int n = n0 + (lane & 31);
#pragma unroll 8
    for (int i = 0; i < 32; ++i) { const int kk = 2 * i + (lane >> 5); scr[kk * 33 + (lane & 31)] = (n < N) ? W[(size_t)(k0 + kk) * N + n] : 0.f; }
    asm volatile("s_waitcnt lgkmcnt(0)" ::: "memory");
    const int c = lane & 7;
#pragma unroll
    for (int j = 0; j < 4; ++j) { const int nn = (lane >> 3) + 8 * j; const LAS float* s = scr + (8 * c) * 33 + nn;
        u32x4 o; o.x = pk2(s[0 * 33], s[1 * 33]); o.y = pk2(s[2 * 33], s[3 * 33]); o.z = pk2(s[4 * 33], s[5 * 33]); o.w = pk2(s[6 * 33], s[7 * 33]);
        *(u32x4*)(WT + (size_t)(out_row0 + nn) * K + k0 + 8 * c) = o; }
    asm volatile("s_waitcnt lgkmcnt(0)" ::: "memory");
}

__device__ __forceinline__ void rms_row(const float* xrow, const float* gain, bf16_t* orow, float* copyrow, int lane) {
    const f32x4* xr = (const f32x4*)xrow + lane; const f32x4* gr = (const f32x4*)gain + lane;
    f32x4 v[4]; float s = 0.f;
#pragma unroll
    for (int j = 0; j < 4; ++j) { v[j] = xr[64 * j]; s += (v[j].x * v[j].x + v[j].y * v[j].y) + (v[j].z * v[j].z + v[j].w * v[j].w); }
    if (copyrow) {
#pragma unroll
        for (int j = 0; j < 4; ++j) ((f32x4*)copyrow + lane)[64 * j] = v[j];
    }
    const float rstd = rsqrtf(wave_sum(s) * (1.f / 1024.f) + EPS);
    unsigned long long* o8 = (unsigned long long*)orow + lane;
#pragma unroll
    for (int j = 0; j < 4; ++j) { const f32x4 gg = gr[64 * j]; const f32x4 y = v[j] * rstd * gg;
        o8[64 * j] = (unsigned long long)pk2(y.x, y.y) | ((unsigned long long)pk2(y.z, y.w) << 32); }
}

__device__ __forceinline__ void phase_prep(const Ctx p, LAS unsigned char* lds) {
    const int tid = opaque_tid(), lane = tid & 63, wave = tid >> 6;
    const int gw = blockIdx.x * 8 + wave, NGW = gridDim.x * 8;
    LAS float* scr = (LAS float*)(lds + wave * 16384);
    constexpr int I_GU = 16 * 176, I_D = 44 * 32, I_IN = 16 * 112, I_OUT = 16 * 32, I_KV = 16 * 64, I_O = 16 * 32;
    constexpr int PER_LAYER = 2 * I_GU + 2 * I_D + I_IN + I_OUT + I_KV + I_O;
    for (int it = gw; it < NL * PER_LAYER; it += NGW) {
        const int l = it / PER_LAYER; int r = it % PER_LAYER;
        unsigned char* wl = p.ws() + WS_W + (size_t)l * LAYER_W;
        const float* W; int K, N, NP; bf16_t* WT; int gu = 0;
        if (r < I_GU) { W = p.in(3) + (size_t)l * 1024 * 5632; K = 1024; N = 5632; NP = 5632; WT = (bf16_t*)(wl + W_GU1); gu = 1; }
        else if ((r -= I_GU) < I_GU) { W = p.in(24) + (size_t)l * 1024 * 5632; K = 1024; N = 5632; NP = 5632; WT = (bf16_t*)(wl + W_GU2); gu = 1; }
        else if ((r -= I_GU) < I_D) { W = p.in(4) + (size_t)l * 2816 * 1024; K = 2816; N = 1024; NP = 1024; WT = (bf16_t*)(wl + W_D1); }
        else if ((r -= I_D) < I_D) { W = p.in(25) + (size_t)l * 2816 * 1024; K = 2816; N = 1024; NP = 1024; WT = (bf16_t*)(wl + W_D2); }
        else if ((r -= I_D) < I_IN) { W = p.in(6) + (size_t)l * 1024 * DIN; K = 1024; N = DIN; NP = DINP; WT = (bf16_t*)(wl + W_IN); }
        else if ((r -= I_IN) < I_OUT) { W = p.in(7) + (size_t)l * 1024 * 1024; K = 1024; N = 1024; NP = 1024; WT = (bf16_t*)(wl + W_OUT); }
        else if ((r -= I_OUT) < I_KV) { W = p.in(21) + (size_t)l * 1024 * 2048; K = 1024; N = 2048; NP = 2048; WT = (bf16_t*)(wl + W_KV); }
        else { r -= I_KV; W = p.in(22) + (size_t)l * 1024 * 1024; K = 1024; N = 1024; NP = 1024; WT = (bf16_t*)(wl + W_O); }
        const int nblk = NP / 32, kb = r / nblk, nb = r % nblk, n0 = nb * 32;
        int orow = n0;
        if (gu) { const int f = (n0 < 2816) ? n0 : n0 - 2816; orow = (f >> 7) * 256 + (f & 127) + ((n0 < 2816) ? 0 : 128); }
        transpose_item(W, K, N, WT, orow, kb * 64, n0, scr, lane);
    }
    const int gt = blockIdx.x * 512 + tid, NGT = gridDim.x * 512;
    for (int i = gt; i < NL * 1024 * 1024 / 4; i += NGT) {
        const int l = i / (1024 * 1024 / 4), e = i % (1024 * 1024 / 4);
        const f32x4 v = ((const f32x4*)(p.in(20) + (size_t)l * 1024 * 1024))[e];
        u32x2 o; o.x = pk2(v.x, v.y); o.y = pk2(v.z, v.w);
        ((u32x2*)(p.ws() + WS_W + (size_t)l * LAYER_W + W_Q))[e] = o;
    }
    float* rc = (float*)(p.ws() + WS_ROPE); float* rs = rc + 4096 * 32;
    for (int i = gt; i < 4096 * 32; i += NGT) {
        const int s = i >> 5, d = i & 31;
        const float ang = (float)s * p.invf(d);
        const float n = rintf(ang * 0.15915494309189535f);
        float r = fmaf(-n, 6.2831854820251465f, ang); r = fmaf(-n, -1.7484555e-07f, r);
        rc[i] = cosf(r); rs[i] = sinf(r);
    }
    for (int m = gw; m < NL * 4096; m += NGW) { const int l = m >> 12, rr = m & 4095;
        rms_row(p.in(1) + (size_t)rr * 1024, p.in(19) + l * 1024, (bf16_t*)(p.ws() + WS_MEMN) + (size_t)m * 1024, nullptr, lane); }
}

__device__ __forceinline__ void phase_norm(const Ctx p, const float* src, const float* gain, float* copy) {
    const int tid_ = opaque_tid(), lane = tid_ & 63, wave = tid_ >> 6;
    const int gw = blockIdx.x * 8 + wave, NGW = gridDim.x * 8;
    bf16_t* hn = (bf16_t*)(p.ws() + WS_HN);
    for (int m = gw; m < TT; m += NGW) rms_row(src + (size_t)m * 1024, gain, hn + (size_t)m * 1024, copy ? copy + (size_t)m * 1024 : nullptr, lane);
}

__device__ __forceinline__ void phase_final(const Ctx p) {
    const int tid_ = opaque_tid(), lane = tid_ & 63, wave = tid_ >> 6;
    const int gw = blockIdx.x * 8 + wave, NGW = gridDim.x * 8;
    const f32x4* gr = (const f32x4*)p.in(26) + lane;
    for (int m = gw; m < TT; m += NGW) {
        f32x4* xr = (f32x4*)(p.out() + (size_t)m * 1024) + lane;
        f32x4 v[4]; float s = 0.f;
#pragma unroll
        for (int j = 0; j < 4; ++j) { v[j] = xr[64 * j]; s += (v[j].x * v[j].x + v[j].y * v[j].y) + (v[j].z * v[j].z + v[j].w * v[j].w); }
        const float rstd = rsqrtf(wave_sum(s) * (1.f / 1024.f) + EPS);
#pragma unroll
        for (int j = 0; j < 4; ++j) xr[64 * j] = v[j] * rstd * gr[64 * j];
    }
}

__device__ __forceinline__ void phase_softmax(const Ctx p) {
    const int tid_ = opaque_tid(), lane = tid_ & 63, wave = tid_ >> 6;
    const int gw = blockIdx.x * 8 + wave, NGW = gridDim.x * 8;
    bf16_t* S = (bf16_t*)(p.ws() + WS_PROJ);
    for (int m = gw; m < TT; m += NGW) {
        u32x4* rp = (u32x4*)(S + (size_t)m * 1024) + lane * 2;
        const u32x4 w0 = rp[0], w1 = rp[1];
        float v[16];
        v[0] = bflo(w0.x); v[1] = bfhi(w0.x); v[2] = bflo(w0.y); v[3] = bfhi(w0.y); v[4] = bflo(w0.z); v[5] = bfhi(w0.z); v[6] = bflo(w0.w); v[7] = bfhi(w0.w);
        v[8] = bflo(w1.x); v[9] = bfhi(w1.x); v[10] = bflo(w1.y); v[11] = bfhi(w1.y); v[12] = bflo(w1.z); v[13] = bfhi(w1.z); v[14] = bflo(w1.w); v[15] = bfhi(w1.w);
        float mx = v[0];
#pragma unroll
        for (int i = 1; i < 16; ++i) mx = fmaxf(mx, v[i]);
#pragma unroll
        for (int o = 1; o < 16; o <<= 1) mx = fmaxf(mx, __shfl_xor(mx, o));
        float sum = 0.f;
#pragma unroll
        for (int i = 0; i < 16; ++i) { v[i] = __expf(v[i] - mx); sum += v[i]; }
#pragma unroll
        for (int o = 1; o < 16; o <<= 1) sum += __shfl_xor(sum, o);
        const float inv = 1.0f / sum;
        u32x4 o0, o1;
        o0.x = pk2(v[0] * inv, v[1] * inv); o0.y = pk2(v[2] * inv, v[3] * inv); o0.z = pk2(v[4] * inv, v[5] * inv); o0.w = pk2(v[6] * inv, v[7] * inv);
        o1.x = pk2(v[8] * inv, v[9] * inv); o1.y = pk2(v[10] * inv, v[11] * inv); o1.z = pk2(v[12] * inv, v[13] * inv); o1.w = pk2(v[14] * inv, v[15] * inv);
        rp[0] = o0; rp[1] = o1;
    }
}

constexpr int PQ = 68;
constexpr int L_A1 = 0, L_A2 = L_A1 + 64 * PQ, L_A3 = L_A2 + 64 * PQ, L_A4 = L_A3 + 64 * PQ, L_A5 = L_A4 + 64 * PQ, L_V = L_A5 + 64 * PQ, L_ST = L_V + 4096,
              L_CL = L_ST + 4096, L_RF = L_CL + 64, L_W2 = L_RF + 64, L_BA = L_W2 + 512, L_MIXEND = L_BA + 32;
static_assert(L_MIXEND * 4 <= LDS_BYTES, "mixer LDS");

__device__ __forceinline__ void unpack8(const u32x4 w, float (&f)[8]) {
    f[0] = bflo(w.x); f[1] = bfhi(w.x); f[2] = bflo(w.y); f[3] = bfhi(w.y); f[4] = bflo(w.z); f[5] = bfhi(w.z); f[6] = bflo(w.w); f[7] = bfhi(w.w);
}
__device__ __forceinline__ void unpack4(const u32x2 w, float (&f)[4]) { f[0] = bflo(w.x); f[1] = bfhi(w.x); f[2] = bflo(w.y); f[3] = bfhi(w.y); }
__device__ __forceinline__ float dot4(const f32x4 a, const f32x4 b) { return (a.x * b.x + a.y * b.y) + (a.z * b.z + a.w * b.w); }

template <int MIX>
__device__ __forceinline__ void gla_chain(const Ctx p, int l, int b, int h, LAS float* sm) {
    constexpr int DK = (MIX == 2) ? 32 : 64;
    constexpr bool CAUSAL = (MIX == 3);
    constexpr int EPT = DK / 8;
    constexpr int QOFF = MIX == 0 ? 0 : (MIX == 2 ? 1536 : 2320);
    constexpr int KOFF = MIX == 0 ? 256 : (MIX == 2 ? 1664 : 2576);
    constexpr int VOFF = MIX == 0 ? 512 : (MIX == 2 ? 1792 : 2832);
    constexpr int GOFF = MIX == 0 ? 768 : (MIX == 2 ? 2064 : 3088);
    constexpr int YOFF = MIX == 0 ? 0 : (MIX == 2 ? 512 : 768);
    const int tid = opaque_tid(), tj = tid >> 4, tm = tid & 15, row = tid >> 3, cgp = tid & 7;
    LAS float* A1 = sm + L_A1; LAS float* A2 = sm + L_A2; LAS float* A3 = sm + L_A3; LAS float* A4 = sm + L_A4; LAS float* A5 = sm + L_A5;
    LAS float* V = sm + L_V; LAS float* ST = sm + L_ST; LAS float* CL = sm + L_CL; LAS float* RF = sm + L_RF;
    const bf16_t* proj = (const bf16_t*)(p.ws() + WS_PROJ) + (size_t)b * SEQ * DINP;
    bf16_t* Y = (bf16_t*)(p.ws() + WS_HN) + (size_t)b * SEQ * 1024;
    float S0[4] = {0.f, 0.f, 0.f, 0.f}, S1[4] = {0.f, 0.f, 0.f, 0.f};
    float lbv[8];
#pragma unroll
    for (int i = 0; i < 8; ++i) lbv[i] = 0.f;
    float lg = 0.f;
    if constexpr (MIX == 0) lg = log1pf(-exp2f(-5.0f - (float)h));
    if constexpr (MIX == 2) {
        const float* w2 = p.in(15) + (size_t)l * 16 * 128; const float* ba = p.in(16) + (size_t)l * 128;
        { const int r = tid >> 5, d = tid & 31; sm[L_W2 + r * 32 + d] = w2[r * 128 + h * 32 + d]; }
        if (tid < 32) sm[L_BA + tid] = ba[h * 32 + tid];
    }
    if constexpr (MIX == 3) {
        const float* lg4 = p.in(17);
#pragma unroll
        for (int i = 0; i < 8; ++i) { const int ch = h * 64 + cgp * 8 + i;
            const float a0 = lg4[ch], a1 = lg4[256 + ch], a2 = lg4[512 + ch], a3 = lg4[768 + ch];
            const float mx = fmaxf(fmaxf(a0, a1), fmaxf(a2, a3));
            const float e0 = expf(a0 - mx), e1 = expf(a1 - mx), e2 = expf(a2 - mx), e3 = expf(a3 - mx);
            const float inv = 1.0f / (e0 + e1 + e2 + e3);
            float lb = 0.f; if (l >= 1) lb += e1 * inv; if (l >= 2) lb += e2 * inv; if (l >= 3) lb += e3 * inv;
            lbv[i] = lb; }
    }
    for (int c = 0; c < 64; ++c) {
        __syncthreads();
        const int t0 = c * 64;
        const bf16_t* pr = proj + (size_t)(t0 + row) * DINP;
        { float vv[8]; unpack8(*(const u32x4*)(pr + VOFF + h * 64 + cgp * 8), vv);
#pragma unroll
          for (int i = 0; i < 8; ++i) V[row * 64 + cgp * 8 + i] = vv[i]; }
        if constexpr (MIX == 0) {
            const int p0 = cgp * 4;
            float q1[4], q2[4], k1[4], k2[4];
            unpack4(*(const u32x2*)(pr + QOFF + h * 64 + p0), q1); unpack4(*(const u32x2*)(pr + QOFF + h * 64 + 32 + p0), q2);
            unpack4(*(const u32x2*)(pr + KOFF + h * 64 + p0), k1); unpack4(*(const u32x2*)(pr + KOFF + h * 64 + 32 + p0), k2);
            const float* rc = (const float*)(p.ws() + WS_ROPE); const float* rs = rc + 4096 * 32;
            const f32x4 cs = *(const f32x4*)(rc + (t0 + row) * 32 + p0), sn = *(const f32x4*)(rs + (t0 + row) * 32 + p0);
#pragma unroll
            for (int i = 0; i < 4; ++i) {
                A1[row * PQ + p0 + i] = q1[i] * cs[i] - q2[i] * sn[i]; A1[row * PQ + 32 + p0 + i] = q1[i] * sn[i] + q2[i] * cs[i];
                A3[row * PQ + p0 + i] = (k1[i] * cs[i] - k2[i] * sn[i]) * 0.125f; A3[row * PQ + 32 + p0 + i] = (k1[i] * sn[i] + k2[i] * cs[i]) * 0.125f;
                A5[row * PQ + p0 + i] = lg; A5[row * PQ + 32 + p0 + i] = lg; }
        } else if constexpr (MIX == 2) {
            const int d0 = cgp * 4;
            float q[4], k[4], al[16];
            unpack4(*(const u32x2*)(pr + QOFF + h * 32 + d0), q); unpack4(*(const u32x2*)(pr + KOFF + h * 32 + d0), k);
            { float t8[8]; unpack8(*(const u32x4*)(pr + 2048), t8);
#pragma unroll
              for (int i = 0; i < 8; ++i) al[i] = t8[i];
              unpack8(*(const u32x4*)(pr + 2056), t8);
#pragma unroll
              for (int i = 0; i < 8; ++i) al[8 + i] = t8[i]; }
#pragma unroll
            for (int i = 0; i < 4; ++i) {
                float a = sm[L_BA + d0 + i];
#pragma unroll
                for (int r = 0; r < 16; ++r) a += al[r] * sm[L_W2 + r * 32 + d0 + i];
                const float ls = -(fmaxf(-a, 0.f) + logf(1.0f + __expf(-fabsf(a))));
                A1[row * PQ + d0 + i] = q[i] * 0.17677669529663687f; A3[row * PQ + d0 + i] = k[i]; A5[row * PQ + d0 + i] = ls * 0.0625f; }
        } else {
            const int d0 = cgp * 8;
            float q[8], f[8];
            unpack8(*(const u32x4*)(pr + QOFF + h * 64 + d0), q); unpack8(*(const u32x4*)(pr + KOFF + h * 64 + d0), f);
#pragma unroll
            for (int i = 0; i < 8; ++i) {
                const float sg = 1.0f / (1.0f + __expf(-f[i])), nsg = 1.0f / (1.0f + __expf(f[i]));
                A1[row * PQ + d0 + i] = siluf_(q[i]); A3[row * PQ + d0 + i] = (1.0f - lbv[i]) * nsg; A5[row * PQ + d0 + i] = logf(lbv[i] + (1.0f - lbv[i]) * sg); }
        }
        __syncthreads();
        if (tid < DK) { float cum = 0.f;
#pragma unroll 8
            for (int j = 0; j < 64; ++j) { cum += A5[j * PQ + tid]; A5[j * PQ + tid] = cum; if (j == 31) RF[tid] = cum; }
            CL[tid] = cum; }
        __syncthreads();
#pragma unroll
        for (int i = 0; i < EPT; ++i) { const int d = cgp * EPT + i, idx = row * PQ + d;
            const float cv = A5[idx], rf = RF[d], e1 = __expf(cv - rf), e2 = __expf(rf - cv), q = A1[idx], k = A3[idx];
            A1[idx] = q * e1; A3[idx] = k * e2;
            if constexpr (!CAUSAL) { A2[idx] = q * e2; A4[idx] = k * e1; } }
        { const float er = __expf(RF[tj]);
          *(LAS f32x4*)(ST + tj * 64 + 4 * tm) = (f32x4){er * S0[0], er * S0[1], er * S0[2], er * S0[3]};
          if constexpr (DK == 64) { const float er1 = __expf(RF[tj + 32]); *(LAS f32x4*)(ST + (tj + 32) * 64 + 4 * tm) = (f32x4){er1 * S1[0], er1 * S1[1], er1 * S1[2], er1 * S1[3]}; } }
        __syncthreads();
        {
            float lo[2][4], up[2][4];
#pragma unroll
            for (int a = 0; a < 2; ++a)
#pragma unroll
                for (int i = 0; i < 4; ++i) { lo[a][i] = 0.f; up[a][i] = 0.f; }
#pragma unroll 4
            for (int d = 0; d < DK; d += 4) {
                const f32x4 qa = *(const LAS f32x4*)(A1 + tj * PQ + d), qb = *(const LAS f32x4*)(A1 + (tj + 32) * PQ + d);
                f32x4 qna = qa, qnb = qb;
                if constexpr (!CAUSAL) { qna = *(const LAS f32x4*)(A2 + tj * PQ + d); qnb = *(const LAS f32x4*)(A2 + (tj + 32) * PQ + d); }
#pragma unroll
                for (int i = 0; i < 4; ++i) { const int m = tm + 16 * i;
                    const f32x4 kn = *(const LAS f32x4*)(A3 + m * PQ + d);
                    lo[0][i] += dot4(qa, kn); lo[1][i] += dot4(qb, kn);
                    if constexpr (!CAUSAL) { const f32x4 kp = *(const LAS f32x4*)(A4 + m * PQ + d); up[0][i] += dot4(qna, kp); up[1][i] += dot4(qnb, kp); } }
            }
#pragma unroll
            for (int a = 0; a < 2; ++a)
#pragma unroll
                for (int i = 0; i < 4; ++i) { const int j = tj + 32 * a, m = tm + 16 * i;
                    A5[j * PQ + m] = (m <= j) ? lo[a][i] : (CAUSAL ? 0.f : up[a][i]); }
        }
        __syncthreads();
        {
            f32x4 o0 = (f32x4){0.f, 0.f, 0.f, 0.f}, o1 = o0;
#pragma unroll 4
            for (int m = 0; m < 64; m += 4) {
                const f32x4 s0 = *(const LAS f32x4*)(A5 + tj * PQ + m), s1 = *(const LAS f32x4*)(A5 + (tj + 32) * PQ + m);
#pragma unroll
                for (int mm = 0; mm < 4; ++mm) { const f32x4 v = *(const LAS f32x4*)(V + (m + mm) * 64 + 4 * tm); o0 += v * s0[mm]; o1 += v * s1[mm]; }
            }
#pragma unroll 4
            for (int d = 0; d < DK; d += 4) {
                const f32x4 qa = *(const LAS f32x4*)(A1 + tj * PQ + d), qb = *(const LAS f32x4*)(A1 + (tj + 32) * PQ + d);
#pragma unroll
                for (int dd = 0; dd < 4; ++dd) { const f32x4 st = *(const LAS f32x4*)(ST + (d + dd) * 64 + 4 * tm); o0 += st * qa[dd]; o1 += st * qb[dd]; }
            }
#pragma unroll
            for (int a = 0; a < 2; ++a) {
                const f32x4 o = a ? o1 : o0; const int j = tj + 32 * a;
                float s = (o.x + o.y) + (o.z + o.w);
#pragma unroll
                for (int x = 1; x < 16; x <<= 1) s += __shfl_xor(s, x);
                const float mu = s * (1.0f / 64.0f);
                const f32x4 dv = o - mu;
                float q = (dv.x * dv.x + dv.y * dv.y) + (dv.z * dv.z + dv.w * dv.w);
#pragma unroll
                for (int x = 1; x < 16; x <<= 1) q += __shfl_xor(q, x);
                const float rstd = rsqrtf(q * (1.0f / 64.0f) + EPS);
                float gt[4]; unpack4(*(const u32x2*)(proj + (size_t)(t0 + j) * DINP + GOFF + h * 64 + 4 * tm), gt);
                u32x2 w; w.x = pk2(siluf_(gt[0]) * dv.x * rstd, siluf_(gt[1]) * dv.y * rstd); w.y = pk2(siluf_(gt[2]) * dv.z * rstd, siluf_(gt[3]) * dv.w * rstd);
                *(u32x2*)(Y + (size_t)(t0 + j) * 1024 + YOFF + h * 64 + 4 * tm) = w;
            }
        }
        {
            f32x4 a0 = (f32x4){0.f, 0.f, 0.f, 0.f}, a1 = a0;
#pragma unroll 8
            for (int m = 0; m < 64; ++m) { const f32x4 v = *(const LAS f32x4*)(V + m * 64 + 4 * tm);
                a0 += v * A3[m * PQ + tj];
                if constexpr (DK == 64) a1 += v * A3[m * PQ + tj + 32]; }
            { const float cl = CL[tj], e = __expf(cl), f = __expf(cl - RF[tj]);
#pragma unroll
              for (int i = 0; i < 4; ++i) S0[i] = e * S0[i] + f * a0[i]; }
            if constexpr (DK == 64) { const float cl = CL[tj + 32], e = __expf(cl), f = __expf(cl - RF[tj + 32]);
#pragma unroll
              for (int i = 0; i < 4; ++i) S1[i] = e * S1[i] + f * a1[i]; }
        }
    }
    __syncthreads();
}

constexpr int L2_WA = 0, L2_WX = 4096, L2_XB = 8192, L2_XC = L2_XB + 4352, L2_AA = L2_XC + 64 * PQ, L2_UU = L2_AA + 4096, L2_CW = L2_UU + 4096, L2_CB = L2_CW + 256, L2_END = L2_CB + 64;
static_assert(L2_END * 4 <= LDS_BYTES, "lru LDS");

__device__ __forceinline__ void lru_chain(const Ctx p, int l, int b, int n, LAS float* sm) {
    const int tid = opaque_tid(), tj = tid >> 4, tm = tid & 15, row = tid >> 3, cgp = tid & 7;
    LAS float* WA = sm + L2_WA; LAS float* WX = sm + L2_WX; LAS float* XB = sm + L2_XB; LAS float* XC = sm + L2_XC; LAS float* AA = sm + L2_AA; LAS float* UU = sm + L2_UU;
    LAS float* CW = sm + L2_CW; LAS float* CB = sm + L2_CB;
    const bf16_t* proj = (const bf16_t*)(p.ws() + WS_PROJ) + (size_t)b * SEQ * DINP;
    bf16_t* Y = (bf16_t*)(p.ws() + WS_HN) + (size_t)b * SEQ * 1024;
    __syncthreads();
    { const float* wa = p.in(10) + ((size_t)l * 4 + n) * 4096; const float* wx = p.in(12) + ((size_t)l * 4 + n) * 4096;
#pragma unroll
      for (int i = 0; i < 8; ++i) { WA[tid + 512 * i] = wa[tid + 512 * i]; WX[tid + 512 * i] = wx[tid + 512 * i]; }
      if (tid < 256) CW[tid] = p.in(8)[(size_t)l * 1024 + (tid >> 6) * 256 + n * 64 + (tid & 63)];
      if (tid < 64) CB[tid] = p.in(9)[(size_t)l * 256 + n * 64 + tid]; }
    float ba[4], bx[4], ls8[4];
#pragma unroll
    for (int i = 0; i < 4; ++i) { const int ch = n * 64 + 4 * tm + i;
        ba[i] = p.in(11)[(size_t)l * 256 + ch]; bx[i] = p.in(13)[(size_t)l * 256 + ch];
        const float lam = p.in(14)[(size_t)l * 256 + ch];
        ls8[i] = -8.0f * (fmaxf(-lam, 0.f) + log1pf(expf(-fabsf(lam)))); }
    float hreg = 0.f;
    for (int c = 0; c < 64; ++c) {
        __syncthreads();
        const int t0 = c * 64;
        { float xv[8]; unpack8(*(const u32x4*)(proj + (size_t)(t0 + row) * DINP + 1024 + n * 64 + cgp * 8), xv);
#pragma unroll
          for (int i = 0; i < 8; ++i) XB[(row + 3) * 64 + cgp * 8 + i] = xv[i]; }
        if (tid < 24) { float xv[8];
            if (c > 0) unpack8(*(const u32x4*)(proj + (size_t)(t0 - 3 + row) * DINP + 1024 + n * 64 + cgp * 8), xv);
            else {
#pragma unroll
                for (int i = 0; i < 8; ++i) xv[i] = 0.f; }
#pragma unroll
            for (int i = 0; i < 8; ++i) XB[row * 64 + cgp * 8 + i] = xv[i]; }
        __syncthreads();
#pragma unroll
        for (int i = 0; i < 8; ++i) { const int ch = cgp * 8 + i;
            XC[row * PQ + ch] = CB[ch] + CW[ch] * XB[row * 64 + ch] + CW[64 + ch] * XB[(row + 1) * 64 + ch] + CW[128 + ch] * XB[(row + 2) * 64 + ch] + CW[192 + ch] * XB[(row + 3) * 64 + ch]; }
        __syncthreads();
        {
            f32x4 r0 = (f32x4){0.f, 0.f, 0.f, 0.f}, r1 = r0, i0 = r0, i1 = r0;
#pragma unroll 4
            for (int d = 0; d < 64; d += 4) {
                const f32x4 x0 = *(const LAS f32x4*)(XC + tj * PQ + d), x1 = *(const LAS f32x4*)(XC + (tj + 32) * PQ + d);
#pragma unroll
                for (int dd = 0; dd < 4; ++dd) { const f32x4 wa = *(const LAS f32x4*)(WA + (d + dd) * 64 + 4 * tm), wx = *(const LAS f32x4*)(WX + (d + dd) * 64 + 4 * tm);
                    r0 += wa * x0[dd]; r1 += wa * x1[dd]; i0 += wx * x0[dd]; i1 += wx * x1[dd]; }
            }
#pragma unroll
            for (int a = 0; a < 2; ++a) { const f32x4 rr = a ? r1 : r0, ii = a ? i1 : i0; const int t = tj + 32 * a;
                f32x4 av, uv;
#pragma unroll
                for (int i = 0; i < 4; ++i) { const float r = sigmoidf_(rr[i] + ba[i]), ig = sigmoidf_(ii[i] + bx[i]);
                    const float la = r * ls8[i]; av[i] = __expf(la); uv[i] = sqrtf(-expm1f(2.0f * la)) * (ig * XC[t * PQ + 4 * tm + i]); }
                *(LAS f32x4*)(AA + t * 64 + 4 * tm) = av; *(LAS f32x4*)(UU + t * 64 + 4 * tm) = uv; }
        }
        __syncthreads();
        if (tid < 64) {
#pragma unroll 8
            for (int t = 0; t < 64; ++t) { hreg = AA[t * 64 + tid] * hreg + UU[t * 64 + tid]; UU[t * 64 + tid] = hreg; } }
        __syncthreads();
        { float gv[8]; unpack8(*(const u32x4*)(proj + (size_t)(t0 + row) * DINP + 1280 + n * 64 + cgp * 8), gv);
          float o[8];
#pragma unroll
          for (int i = 0; i < 8; ++i) { const float x = gv[i], z = 0.7978845608028654f * (x + 0.044715f * x * x * x);
              const float th = 1.0f - 2.0f / (1.0f + __expf(2.0f * z)); o[i] = UU[row * 64 + cgp * 8 + i] * 0.5f * x * (1.0f + th); }
          u32x4 w; w.x = pk2(o[0], o[1]); w.y = pk2(o[2], o[3]); w.z = pk2(o[4], o[5]); w.w = pk2(o[6], o[7]);
          *(u32x4*)(Y + (size_t)(t0 + row) * 1024 + 256 + n * 64 + cgp * 8) = w; }
    }
    __syncthreads();
}

__device__ __forceinline__ void phase_mix(const Ctx p, int l, LAS unsigned char* lds) {
    LAS float* sm = (LAS float*)lds;
    for (int cid = blockIdx.x; cid < 256; cid += gridDim.x) {
        const int mixer = cid & 3, w = cid >> 2, b = w >> 2, h = w & 3;
        if (mixer == 0) gla_chain<0>(p, l, b, h, sm);
        else if (mixer == 1) lru_chain(p, l, b, h, sm);
        else if (mixer == 2) gla_chain<2>(p, l, b, h, sm);
        else gla_chain<3>(p, l, b, h, sm);
    }
}

enum { T_PREP = 0, T_NORM, T_GBF, T_GSWI, T_GRES, T_MIX, T_SOFTMAX, T_FINAL };
constexpr int NSTEPS = 2 + 16 * NL + 1;
__host__ __device__ __forceinline__ void decode_step(int st, int& type, int& l, int& sub, bool& sync) {
    sync = true; l = 0; sub = 0;
    if (st == 0) { type = T_PREP; return; }
    if (st == 1) { type = T_GBF; sub = 0; return; }
    if (st == NSTEPS - 1) { type = T_FINAL; return; }
    const int r = (st - 2) & 15; l = (st - 2) >> 4;
    switch (r) {
        case 0: type = T_NORM; sub = 0; break;
        case 1: type = T_GSWI; sub = 0; break;
        case 2: type = T_GRES; sub = 0; break;
        case 3: type = T_NORM; sub = 1; break;
        case 4: type = T_GBF; sub = 1; break;
        case 5: type = T_MIX; break;
        case 6: type = T_GRES; sub = 1; break;
        case 7: type = T_NORM; sub = 2; sync = false; break;
        case 8: type = T_GBF; sub = 2; sync = false; break;
        case 9: type = T_GBF; sub = 3; break;
        case 10: type = T_GBF; sub = 4; break;
        case 11: type = T_SOFTMAX; break;
        case 12: type = T_GRES; sub = 2; break;
        case 13: type = T_NORM; sub = 3; break;
        case 14: type = T_GSWI; sub = 1; break;
        default: type = T_GRES; sub = 3; break;
    }
}

__global__ void __launch_bounds__(512, 2) fwd_kernel(Params pk) {
    extern __shared__ __attribute__((aligned(16))) unsigned char lds_raw[];
    LAS unsigned char* lds = (LAS unsigned char*)lds_raw;
    { const unsigned* ka = (const unsigned*)__builtin_amdgcn_kernarg_segment_ptr();
      if (threadIdx.x < sizeof(Params) / 4) ((LAS unsigned*)(lds + PARAM_OFF))[threadIdx.x] = ka[threadIdx.x]; }
    __syncthreads();
    Ctx p; p.lds = lds;
    const int G = gridDim.x, c = blockIdx.x;
    const int st_hi = p.hi();
    for (int st = p.lo(); st < st_hi; ++st) {
        unsigned char* ws = p.ws();
        int type, l, sub; bool sync;
        decode_step(st, type, l, sub, sync);
        const char* wl = (const char*)(ws + WS_W + (size_t)l * LAYER_W);
        if (type == T_PREP) phase_prep(p, lds);
        else if (type == T_NORM) {
            const float* gain = (sub == 0 ? p.in(2) : sub == 1 ? p.in(5) : sub == 2 ? p.in(18) : p.in(23)) + (size_t)l * 1024;
            const bool first = (l == 0 && sub == 0);
            phase_norm(p, first ? p.in(0) : p.out(), gain, first ? p.out() : nullptr);
        } else if (type == T_GBF) {
            pg8::Gemm g; pg8::Sched S; pg8::EpiBf16 E; S.G = G; S.c = c; S.bB = 0; E.sc = 1.0f; S.nM = 1; S.nN = 1;
            if (sub == 0) { g = {(const char*)(ws + WS_MEMN), (const char*)(ws + WS_W + W_KV), 1024, 1024, 1024}; S.kind = 2; S.nwg = 512; S.tA = 256 * 1024 * 2; S.tB = 256 * 1024 * 2; S.ldc = 2048; S.cw = 256; E.O = (bf16_t*)(ws + WS_KV); E.ldc = 2048; }
            else if (sub == 1) { g = {(const char*)(ws + WS_HN), wl + W_IN, 1024, 1024, 1024}; S.kind = 0; S.nM = 256; S.nN = 14; S.nwg = 256 * 14; S.tA = 256 * 1024 * 2; S.tB = 256 * 1024 * 2; S.ldc = DINP; S.cw = 256; E.O = (bf16_t*)(ws + WS_PROJ); E.ldc = DINP; }
            else if (sub == 2) { g = {(const char*)(ws + WS_KV + (size_t)l * 4096 * 2048 * 2), wl + W_Q, 2048, 1024, 256}; S.kind = 3; S.nwg = 256; S.tA = 0; S.tB = 0; S.ldc = 1024; S.cw = 256; E.O = (bf16_t*)(ws + WS_XM); E.ldc = 1024; }
            else if (sub == 3) { g = {wl + W_O, (const char*)(ws + WS_KV + (size_t)l * 4096 * 2048 * 2), 1024, 2048, 256}; S.kind = 4; S.nwg = 256; S.tA = 0; S.tB = 0; S.ldc = 1024; S.cw = 256; E.O = (bf16_t*)(ws + WS_XN); E.ldc = 1024; }
            else { g = {(const char*)(ws + WS_HN), (const char*)(ws + WS_XM), 1024, 1024, 1024}; S.kind = 1; S.nM = 256; S.nN = 4; S.nwg = 1024; S.tA = 256 * 1024 * 2; S.tB = 256 * 1024 * 2; S.bB = (size_t)1024 * 1024 * 2; S.ldc = 1024; S.cw = 256; E.O = (bf16_t*)(ws + WS_PROJ); E.ldc = 1024; E.sc = 0.0625f; }
            pg8::gemm_phase<pg8::EpiBf16>(lds, g, S, E);
        } else if (type == T_GSWI) {
            pg8::Gemm g = {(const char*)(ws + WS_HN), wl + (sub == 0 ? W_GU1 : W_GU2), 1024, 1024, 1024};
            pg8::Sched S; S.kind = 0; S.nM = 256; S.nN = 22; S.nwg = 256 * 22; S.G = G; S.c = c; S.ldc = FF; S.cw = 128; S.tA = 256 * 1024 * 2; S.tB = 256 * 1024 * 2; S.bB = 0;
            pg8::EpiSwi E; E.O = (bf16_t*)(ws + WS_PROJ); E.ldc = FF;
            pg8::gemm_phase<pg8::EpiSwi>(lds, g, S, E);
        } else if (type == T_GRES) {
            pg8::Gemm g; pg8::Sched S; pg8::EpiRes E; S.kind = 0; S.nM = 256; S.nN = 4; S.nwg = 1024; S.G = G; S.c = c; S.ldc = 1024; S.cw = 256; S.bB = 0; E.X = p.out(); E.sc = 1.0f;
            if (sub == 0 || sub == 3) { g = {(const char*)(ws + WS_PROJ), wl + (sub == 0 ? W_D1 : W_D2), FF, FF, FF}; S.tA = (size_t)256 * FF * 2; S.tB = (size_t)256 * FF * 2; E.sc = 0.5f; }
            else if (sub == 1) { g = {(const char*)(ws + WS_HN), wl + W_OUT, 1024, 1024, 1024}; S.tA = 256 * 1024 * 2; S.tB = 256 * 1024 * 2; }
            else { g = {(const char*)(ws + WS_PROJ), (const char*)(ws + WS_XN), 1024, 1024, 1024}; S.kind = 1; S.tA = 256 * 1024 * 2; S.tB = 256 * 1024 * 2; S.bB = (size_t)1024 * 1024 * 2; }
            pg8::gemm_phase<pg8::EpiRes>(lds, g, S, E);
        } else if (type == T_MIX) phase_mix(p, l, lds);
        else if (type == T_SOFTMAX) phase_softmax(p);
        else phase_final(p);
        if (sync && st + 1 < st_hi) { cg::this_grid().sync(); }
    }
}

extern "C" void kernel_launch(void* const* d_in, const int* in_sizes, int n_in, void* d_out, int out_size, void* d_ws, size_t ws_size, hipStream_t stream) {
    static int grid = 0;
    if (grid == 0) {
        if (n_in != 27 || out_size != TT * DM || ws_size < WS_END) { fprintf(stderr, "kernel_launch: unexpected shapes (n_in %d out %d ws %zu)\n", n_in, out_size, ws_size); grid = -1; return; }
        int dev = 0, cus = 0, per_cu = 0;
        hipGetDevice(&dev); hipDeviceGetAttribute(&cus, hipDeviceAttributeMultiprocessorCount, dev);
        hipFuncSetAttribute((const void*)fwd_kernel, hipFuncAttributeMaxDynamicSharedMemorySize, LDS_BYTES);
        hipOccupancyMaxActiveBlocksPerMultiprocessor(&per_cu, (const void*)fwd_kernel, 512, LDS_BYTES);
        if (per_cu < 1) per_cu = 1;
        grid = cus * per_cu;
        (void)hipGetLastError();
    }
    if (grid < 0) return;
    Params p{};
    for (int i = 0; i < 27; ++i) p.in[i] = (const float*)d_in[i];
    p.out = (float*)d_out; p.ws = (unsigned char*)d_ws;
    for (int d = 0; d < 32; ++d) p.inv_freq[d] = powf(10000.0f, -(float)d / 32.0f);
#if MK_ONE_LAUNCH
    p.lo = 0; p.hi = NSTEPS;
    void* args[] = {&p};
    hipError_t e = hipLaunchCooperativeKernel((const void*)fwd_kernel, dim3(grid), dim3(512), args, LDS_BYTES, stream);
    if (e != hipSuccess) fprintf(stderr, "cooperative launch failed: %s (grid %d)\n", hipGetErrorString(e), grid);
#else
    int lo = 0;
    for (int st = 0; st < NSTEPS; ++st) {
        int type, l, sub; bool sync; decode_step(st, type, l, sub, sync);
        if (sync || st == NSTEPS - 1) { p.lo = lo; p.hi = st + 1; hipLaunchKernelGGL(fwd_kernel, dim3(grid), dim3(512), LDS_BYTES, stream, p); lo = st + 1; }
    }
#endif
}
```

```cpp
#include <hip/hip_runtime.h>
#include <hip/hip_cooperative_groups.h>
#include <cstdio>
#include <cstdint>
#include <cmath>
namespace cg = cooperative_groups;

#ifndef REP_MIX
#define REP_MIX 1
#endif
#ifndef REP_NORM
#define REP_NORM 1
#endif
#ifndef MK_ONE_LAUNCH
#define MK_ONE_LAUNCH 1
#endif

#define LAS __attribute__((address_space(3)))
typedef unsigned short bf16_t;
typedef short bf16x8 __attribute__((ext_vector_type(8)));
typedef float f32x4 __attribute__((ext_vector_type(4)));
typedef unsigned u32x4 __attribute__((ext_vector_type(4)));
typedef unsigned u32x2 __attribute__((ext_vector_type(2)));

constexpr int TT = 65536, DM = 1024, FF = 2816, DIN = 3344, DINP = 3584, NL = 4, SEQ = 4096;
constexpr float EPS = 1e-6f;
constexpr size_t MiB = 1u << 20;
constexpr size_t WS_ROPE = 1 * MiB;
constexpr size_t WS_W = 2 * MiB, LAYER_W = 50 * MiB;
constexpr size_t W_GU1 = 0, W_D1 = 11 * MiB, W_IN = W_D1 + 5632 * 1024, W_OUT = W_IN + 7 * MiB, W_Q = W_OUT + 2 * MiB, W_KV = W_Q + 2 * MiB,
                 W_O = W_KV + 4 * MiB, W_GU2 = W_O + 2 * MiB, W_D2 = W_GU2 + 11 * MiB;
static_assert(W_D2 + 5632 * 1024 == LAYER_W, "weight map");
constexpr size_t WS_MEMN = 202 * MiB;
constexpr size_t WS_KV = 234 * MiB;
constexpr size_t WS_HN = 298 * MiB;
constexpr size_t WS_PROJ = 426 * MiB;
constexpr size_t WS_XM = WS_PROJ + 128 * MiB;
constexpr size_t WS_XN = WS_PROJ + 160 * MiB;
constexpr size_t WS_END = 874 * MiB;

struct Params {
    const float* in[27];
    float* out; unsigned char* ws;
    float inv_freq[32];
    int lo, hi;
};


constexpr int LDS_BYTES = 147456;
constexpr int PARAM_OFF = LDS_BYTES - 1024;
struct Ctx {
    LAS unsigned char* lds;
    __device__ __forceinline__ unsigned long long q(int i) const { const LAS unsigned* pw = (const LAS unsigned*)(lds + PARAM_OFF) + 2 * i;
        const unsigned lo = __builtin_amdgcn_readfirstlane(pw[0]), hi = __builtin_amdgcn_readfirstlane(pw[1]); return ((unsigned long long)hi << 32) | lo; }
    __device__ __forceinline__ const float* in(int i) const { return (const float*)q(i); }
    __device__ __forceinline__ float* out() const { return (float*)q(27); }
    __device__ __forceinline__ unsigned char* ws() const { return (unsigned char*)q(28); }
    __device__ __forceinline__ float invf(int d) const { return ((const LAS float*)(lds + PARAM_OFF))[58 + d]; }
    __device__ __forceinline__ int lo() const { return __builtin_amdgcn_readfirstlane(((const LAS int*)(lds + PARAM_OFF))[90]); }
    __device__ __forceinline__ int hi() const { return __builtin_amdgcn_readfirstlane(((const LAS int*)(lds + PARAM_OFF))[91]); }
};
static_assert(sizeof(Params) == 368, "Params layout");

__device__ __forceinline__ int opaque_tid() { int t = threadIdx.x; asm volatile("" : "+v"(t)); return t; }
__device__ __forceinline__ unsigned f2bf(float f) { unsigned u = __float_as_uint(f); return (u + 0x7fffu + ((u >> 16) & 1u)) >> 16; }
__device__ __forceinline__ unsigned pk2(float lo, float hi) { return f2bf(lo) | (f2bf(hi) << 16); }
__device__ __forceinline__ float bflo(unsigned w) { return __uint_as_float(w << 16); }
__device__ __forceinline__ float bfhi(unsigned w) { return __uint_as_float(w & 0xffff0000u); }
__device__ __forceinline__ float sigmoidf_(float x) { return 1.0f / (1.0f + __expf(-x)); }
__device__ __forceinline__ float siluf_(float x) { return x / (1.0f + __expf(-x)); }
__device__ __forceinline__ float wave_sum(float v) {
#pragma unroll
    for (int o = 1; o < 64; o <<= 1) v += __shfl_xor(v, o);
    return v;
}

namespace pg8 {
constexpr int BM = 256, BK = 64, HALF = 128, HTB = HALF * BK * 2, STAGE_BYTES = 8 * HTB, NXCD = 8, WGM = 8;
__host__ __device__ __forceinline__ int lds_byte(int r, int c) { const int st = (r >> 4) * 2 + (c >> 5), rr = r & 15, cc = c & 31, ob = rr * 64 + cc * 2; return st * 1024 + (ob ^ (((ob >> 9) & 1) << 5)); }
__host__ __device__ __forceinline__ void stage_rc(int b, int& R, int& C) { const int st = b / 1024, sb = b % 1024, swz = sb ^ (((sb >> 9) & 1) << 5); R = (st >> 1) * 16 + swz / 64; C = (st & 1) * 32 + (swz % 64) / 2; }
__host__ __device__ __forceinline__ int perm32(int rho) { const int n = rho >> 4, i = rho & 15; return 8 * (i >> 2) + 4 * n + (i & 3); }

struct Unit { size_t offA, offB, offC; };
struct Gemm { const char* A; const char* Bt; int lda, ldb, K; };

struct Sched {
    int kind, nM, nN, nwg, G, c, ldc, cw;
    size_t tA, tB, bB;
    __device__ __forceinline__ bool next(int i, Unit& u) const {
        const long L = (long)i * G + c; if (L >= nwg) return false;
        if (kind <= 1) {
            int wgid = (int)L; { const int q = nwg / NXCD, r = nwg % NXCD, xcd = wgid % NXCD, off = wgid / NXCD; wgid = (xcd < r ? xcd * (q + 1) : r * (q + 1) + (xcd - r) * q) + off; }
            const int nig = WGM * nN, gid = wgid / nig, fm = gid * WGM, gsz = (nM - fm) < WGM ? (nM - fm) : WGM;
            const int pm = fm + ((wgid % nig) % gsz), pn = (wgid % nig) / gsz;
            u.offA = (size_t)pm * tA; u.offB = (size_t)pn * tB + (kind == 1 ? (size_t)(pm >> 4) * bB : (size_t)0); u.offC = (size_t)pm * 256 * ldc + (size_t)pn * cw;
        } else if (kind == 2) {
            const int ll = (int)L >> 7, r = (int)L & 127, pm = r >> 3, pn = r & 7;
            u.offA = (size_t)ll * (4096 * 1024 * 2) + (size_t)pm * tA; u.offB = (size_t)ll * LAYER_W + (size_t)pn * tB; u.offC = (size_t)ll * (4096 * 2048) + (size_t)pm * 256 * 2048 + (size_t)pn * 256;
        } else if (kind == 3) {
            const int z = (int)L >> 2, pn = (int)L & 3, b = z >> 2, h = z & 3;
            u.offA = ((size_t)(b * 256) * 2048 + h * 256) * 2; u.offB = ((size_t)pn * 256 * 1024 + h * 256) * 2; u.offC = (size_t)b * 1024 * 1024 + (size_t)(h * 256) * 1024 + pn * 256;
        } else {
            const int z = (int)L >> 2, pm = (int)L & 3, b = z >> 2, h = z & 3;
            u.offA = ((size_t)pm * 256 * 1024 + h * 256) * 2; u.offB = ((size_t)(b * 256) * 2048 + 1024 + h * 256) * 2; u.offC = (size_t)b * 1024 * 1024 + (size_t)(pm * 256) * 1024 + h * 256;
        }
        return true;
    }
};

__device__ __forceinline__ unsigned cvt_pk_bf16(float lo, float hi) { unsigned r; asm volatile("v_cvt_pk_bf16_f32 %0, %1, %2" : "=v"(r) : "v"(lo), "v"(hi)); return r; }

struct EpiBf16 {
    static constexpr bool PERM = true;
    bf16_t* O; int ldc; float sc;
    __device__ __forceinline__ void operator()(const f32x4 (&acc)[2][2][4][2], const Unit& u, int wr, int wc, int fr, int fq) const {
        bf16_t* base = O + u.offC + (size_t)(wr * 64 + fr) * ldc + wc * 32 + 8 * fq;
#pragma unroll
        for (int ai = 0; ai < 2; ++ai)
#pragma unroll
            for (int m = 0; m < 4; ++m) { bf16_t* rowp = base + (size_t)(ai * HALF + m * 16) * ldc;
#pragma unroll
                for (int bj = 0; bj < 2; ++bj) { const f32x4 v0 = acc[ai][bj][m][0] * sc, v1 = acc[ai][bj][m][1] * sc;
                    u32x4 w; w.x = cvt_pk_bf16(v0[0], v0[1]); w.y = cvt_pk_bf16(v0[2], v0[3]); w.z = cvt_pk_bf16(v1[0], v1[1]); w.w = cvt_pk_bf16(v1[2], v1[3]);
                    *(u32x4*)(rowp + bj * HALF) = w; } }
    }
};
struct EpiSwi {
    static constexpr bool PERM = true;
    bf16_t* O; int ldc;
    __device__ __forceinline__ void operator()(const f32x4 (&acc)[2][2][4][2], const Unit& u, int wr, int wc, int fr, int fq) const {
        bf16_t* base = O + u.offC + (size_t)(wr * 64 + fr) * ldc + wc * 32 + 8 * fq;
#pragma unroll
        for (int ai = 0; ai < 2; ++ai)
#pragma unroll
            for (int m = 0; m < 4; ++m) { bf16_t* rowp = base + (size_t)(ai * HALF + m * 16) * ldc;
                float r[8];
#pragma unroll
                for (int n = 0; n < 2; ++n)
#pragma unroll
                    for (int e = 0; e < 4; ++e) { const float g = acc[ai][0][m][n][e], up = acc[ai][1][m][n][e]; r[n * 4 + e] = g * __builtin_amdgcn_rcpf(1.0f + __expf(-g)) * up; }
                u32x4 w; w.x = cvt_pk_bf16(r[0], r[1]); w.y = cvt_pk_bf16(r[2], r[3]); w.z = cvt_pk_bf16(r[4], r[5]); w.w = cvt_pk_bf16(r[6], r[7]);
                *(u32x4*)rowp = w; }
    }
};
struct EpiRes {
    static constexpr bool PERM = false;
    float* X; float sc;
    __device__ __forceinline__ void operator()(const f32x4 (&acc)[2][2][4][2], const Unit& u, int wr, int wc, int fr, int fq) const {
        float* base = X + u.offC + (size_t)(wr * 64 + fr) * 1024 + wc * 32 + 4 * fq;
#pragma unroll
        for (int ai = 0; ai < 2; ++ai)
#pragma unroll
            for (int m = 0; m < 4; ++m) { float* rowp = base + (size_t)(ai * HALF + m * 16) * 1024;
#pragma unroll
                for (int bj = 0; bj < 2; ++bj)
#pragma unroll
                    for (int n = 0; n < 2; ++n) { f32x4* q = (f32x4*)(rowp + bj * HALF + n * 16); *q = *q + acc[ai][bj][m][n] * sc; } }
    }
};

template <class Epi>
__device__ __forceinline__ void gemm_phase(LAS unsigned char* lds, const Gemm g, const Sched& S, const Epi& E) {
    const int tid = opaque_tid(), wid = __builtin_amdgcn_readfirstlane(tid >> 6), lane = tid & 63, wr = wid >> 2, wc = wid & 3, fr = lane & 15, fq = lane >> 4;
    const int K = g.K, nt = K / BK;
    unsigned voffA[2], voffB[2];
#pragma unroll
    for (int i = 0; i < 2; ++i) { int R, C; stage_rc(tid * 16 + i * 8192, R, C); const int Rb = Epi::PERM ? ((R & ~31) + perm32(R & 31)) : R;
        voffA[i] = (unsigned)(R * g.lda + C) * 2u; voffB[i] = (unsigned)(Rb * g.ldb + C) * 2u; }
    const size_t kstep = (size_t)(BK * 2);
    const size_t hstepA = (size_t)HALF * g.lda * 2, hstepB = (size_t)HALF * g.ldb * 2;
    const unsigned ldsw = (unsigned)wid * 1024u;
    const int aoff = lds_byte(wr * 64 + fr, fq * 8), boff = lds_byte(wc * 32 + fr, fq * 8);
#define PG8_SA(b, h) (((b) * 2 + (h)) * HTB)
#define PG8_SB(b, h) ((4 + (b) * 2 + (h)) * HTB)
#define PG8_STAGE(bufoff, gbase, voff) do { _Pragma("unroll") for (int _i = 0; _i < 2; ++_i) \
        __builtin_amdgcn_global_load_lds((const unsigned*)((const char*)(gbase) + (voff)[_i]), (LAS unsigned*)(lds + (bufoff) + ldsw + _i * 8192), 16, 0, 0); } while (0)
#define PG8_LDA(dst, b, h) do { _Pragma("unroll") for (int m = 0; m < 4; ++m) _Pragma("unroll") for (int k = 0; k < 2; ++k) dst[m][k] = *(const LAS bf16x8*)(lds + PG8_SA(b, h) + aoff + m * 2048 + k * 1024); } while (0)
#define PG8_LDB(dst, b, h) do { _Pragma("unroll") for (int n = 0; n < 2; ++n) _Pragma("unroll") for (int k = 0; k < 2; ++k) dst[n][k] = *(const LAS bf16x8*)(lds + PG8_SB(b, h) + boff + n * 2048 + k * 1024); } while (0)
#define PG8_MMA(ai, bj, At, Bt) do { __builtin_amdgcn_s_setprio(1); _Pragma("unroll") for (int m = 0; m < 4; ++m) _Pragma("unroll") for (int n = 0; n < 2; ++n) _Pragma("unroll") for (int k = 0; k < 2; ++k) \
        acc[ai][bj][m][n] = __builtin_amdgcn_mfma_f32_16x16x32_bf16(Bt[n][k], At[m][k], acc[ai][bj][m][n], 0, 0, 0); __builtin_amdgcn_s_setprio(0); } while (0)
#define PG8_WAIT_V(n) asm volatile("s_waitcnt vmcnt(" #n ")" ::: "memory")
#define PG8_WAIT_L(n) asm volatile("s_waitcnt lgkmcnt(" #n ")" ::: "memory")
#define PG8_BAR __builtin_amdgcn_s_barrier()
#define PG8_SCHED __builtin_amdgcn_sched_barrier(0)
    Unit cur, nxt; int ui = 0;
    if (!S.next(0, cur)) return;
    f32x4 acc[2][2][4][2];
#pragma unroll
    for (int a = 0; a < 2; ++a)
#pragma unroll
        for (int b = 0; b < 2; ++b)
#pragma unroll
            for (int m = 0; m < 4; ++m)
#pragma unroll
                for (int n = 0; n < 2; ++n) acc[a][b][m][n] = (f32x4){0.f, 0.f, 0.f, 0.f};
    bf16x8 At[4][2], B0[2][2], B1[2][2];
    const char* cA = g.A + cur.offA; const char* cB = g.Bt + cur.offB;
    PG8_STAGE(PG8_SB(0, 0), cB, voffB); PG8_STAGE(PG8_SB(0, 1), cB + hstepB, voffB); PG8_STAGE(PG8_SA(0, 0), cA, voffA); PG8_STAGE(PG8_SA(0, 1), cA + hstepA, voffA);
    if (wr == 1) PG8_BAR;
    PG8_WAIT_V(2); PG8_BAR;
    PG8_STAGE(PG8_SB(1, 0), cB + kstep, voffB); PG8_STAGE(PG8_SA(1, 0), cA + kstep, voffA); PG8_STAGE(PG8_SB(1, 1), cB + hstepB + kstep, voffB);
    PG8_WAIT_V(6); PG8_BAR;
    for (;;) {
        const bool has_next = S.next(ui + 1, nxt);
        const char* nA = has_next ? g.A + nxt.offA : cA; const char* nB = has_next ? g.Bt + nxt.offB : cB;
        for (int t = 0; t < nt; t += 2) {
            const bool last = (t == nt - 2);
            const char* a1 = cA + (size_t)(t + 1) * kstep;
            const char* a2 = last ? nA : cA + (size_t)(t + 2) * kstep; const char* b2 = last ? nB : cB + (size_t)(t + 2) * kstep;
            const char* a3 = a2 + kstep; const char* b3 = b2 + kstep;
            PG8_LDB(B0, 0, 0); PG8_LDB(B1, 0, 1); PG8_SCHED; PG8_LDA(At, 0, 0); PG8_STAGE(PG8_SA(1, 1), a1 + hstepA, voffA);
            PG8_WAIT_V(8); PG8_WAIT_L(0); PG8_BAR; PG8_MMA(0, 0, At, B0); PG8_MMA(0, 1, At, B1); PG8_BAR; PG8_SCHED;
            PG8_LDA(At, 0, 1); PG8_STAGE(PG8_SB(0, 0), b2, voffB); PG8_STAGE(PG8_SB(0, 1), b2 + hstepB, voffB); PG8_STAGE(PG8_SA(0, 0), a2, voffA);
            PG8_WAIT_V(8); PG8_WAIT_L(0); PG8_BAR; PG8_MMA(1, 0, At, B0); PG8_MMA(1, 1, At, B1); PG8_BAR; PG8_SCHED;
            PG8_LDB(B0, 1, 0); PG8_LDB(B1, 1, 1); PG8_SCHED; PG8_LDA(At, 1, 0); PG8_STAGE(PG8_SA(0, 1), a2 + hstepA, voffA);
            PG8_WAIT_V(8); PG8_WAIT_L(0); PG8_BAR; PG8_MMA(0, 0, At, B0); PG8_MMA(0, 1, At, B1); PG8_BAR; PG8_SCHED;
            PG8_LDA(At, 1, 1); PG8_STAGE(PG8_SB(1, 0), b3, voffB); PG8_STAGE(PG8_SB(1, 1), b3 + hstepB, voffB); PG8_STAGE(PG8_SA(1, 0), a3, voffA);
            PG8_WAIT_V(8); PG8_WAIT_L(0); PG8_BAR; PG8_MMA(1, 0, At, B0); PG8_MMA(1, 1, At, B1); PG8_BAR; PG8_SCHED;
        }
        if (wr == 0) PG8_BAR;
        E(acc, cur, wr, wc, fr, fq);
        if (!has_next) break;
#pragma unroll
        for (int a = 0; a < 2; ++a)
#pragma unroll
            for (int b = 0; b < 2; ++b)
#pragma unroll
                for (int m = 0; m < 4; ++m)
#pragma unroll
                    for (int n = 0; n < 2; ++n) acc[a][b][m][n] = (f32x4){0.f, 0.f, 0.f, 0.f};
        cur = nxt; cA = nA; cB = nB; ++ui;
        if (wr == 1) PG8_BAR;
    }
    PG8_WAIT_V(0);
    PG8_BAR;
#undef PG8_SA
#undef PG8_SB
#undef PG8_STAGE
#undef PG8_LDA
#undef PG8_LDB
#undef PG8_MMA
#undef PG8_WAIT_V
#undef PG8_WAIT_L
#undef PG8_BAR
#undef PG8_SCHED
}
}

__device__ __forceinline__ void transpose_item(const float* W, int K, int N, bf16_t* WT, int out_row0, int k0, int n0, LAS float* scr, int lane) {
    const int n = n0 + (lane & 31);
#pragma unroll 8
    for (int i = 0; i < 32; ++i) { const int kk = 2 * i + (lane >> 5); scr[kk * 33 + (lane & 31)] = (n < N) ? W[(size_t)(k0 + kk) * N + n] : 0.f; }
    asm volatile("s_waitcnt lgkmcnt(0)" ::: "memory");
    const int c = lane & 7;
#pragma unroll
    for (int j = 0; j < 4; ++j) { const int nn = (lane >> 3) + 8 * j; const LAS float* s = scr + (8 * c) * 33 + nn;
        u32x4 o; o.x = pk2(s[0 * 33], s[1 * 33]); o.y = pk2(s[2 * 33], s[3 * 33]); o.z = pk2(s[4 * 33], s[5 * 33]); o.w = pk2(s[6 * 33], s[7 * 33]);
        *(u32x4*)(WT + (size_t)(out_row0 + nn) * K + k0 + 8 * c) = o; }
    asm volatile("s_waitcnt lgkmcnt(0)" ::: "memory");
}

__device__ __forceinline__ void rms_row(const float* xrow, const float* gain, bf16_t* orow, float* copyrow, int lane) {
    const f32x4* xr = (const f32x4*)xrow + lane; const f32x4* gr = (const f32x4*)gain + lane;
    f32x4 v[4]; float s = 0.f;
#pragma unroll
    for (int j = 0; j < 4; ++j) { v[j] = xr[64 * j]; s += (v[j].x * v[j].x + v[j].y * v[j].y) + (v[j].z * v[j].z + v[j].w * v[j].w); }
    if (copyrow) {
#pragma unroll
        for (int j = 0; j < 4; ++j) ((f32x4*)copyrow + lane)[64 * j] = v[j];
    }
    const float rstd = rsqrtf(wave_sum(s) * (1.f / 1024.f) + EPS);
    unsigned long long* o8 = (unsigned long long*)orow + lane;
#pragma unroll
    for (int j = 0; j < 4; ++j) { const f32x4 gg = gr[64 * j]; const f32x4 y = v[j] * rstd * gg;
        o8[64 * j] = (unsigned long long)pk2(y.x, y.y) | ((unsigned long long)pk2(y.z, y.w) << 32); }
}

__device__ __forceinline__ void phase_prep(const Ctx p, LAS unsigned char* lds) {
    const int tid = opaque_tid(), lane = tid & 63, wave = tid >> 6;
    const int gw = blockIdx.x * 8 + wave, NGW = gridDim.x * 8;
    LAS float* scr = (LAS float*)(lds + wave * 16384);
    constexpr int I_GU = 16 * 176, I_D = 44 * 32, I_IN = 16 * 112, I_OUT = 16 * 32, I_KV = 16 * 64, I_O = 16 * 32;
    constexpr int PER_LAYER = 2 * I_GU + 2 * I_D + I_IN + I_OUT + I_KV + I_O;
    for (int it = gw; it < NL * PER_LAYER; it += NGW) {
        const int l = it / PER_LAYER; int r = it % PER_LAYER;
        unsigned char* wl = p.ws() + WS_W + (size_t)l * LAYER_W;
        const float* W; int K, N, NP; bf16_t* WT; int gu = 0;
        if (r < I_GU) { W = p.in(3) + (size_t)l * 1024 * 5632; K = 1024; N = 5632; NP = 5632; WT = (bf16_t*)(wl + W_GU1); gu = 1; }
        else if ((r -= I_GU) < I_GU) { W = p.in(24) + (size_t)l * 1024 * 5632; K = 1024; N = 5632; NP = 5632; WT = (bf16_t*)(wl + W_GU2); gu = 1; }
        else if ((r -= I_GU) < I_D) { W = p.in(4) + (size_t)l * 2816 * 1024; K = 2816; N = 1024; NP = 1024; WT = (bf16_t*)(wl + W_D1); }
        else if ((r -= I_D) < I_D) { W = p.in(25) + (size_t)l * 2816 * 1024; K = 2816; N = 1024; NP = 1024; WT = (bf16_t*)(wl + W_D2); }
        else if ((r -= I_D) < I_IN) { W = p.in(6) + (size_t)l * 1024 * DIN; K = 1024; N = DIN; NP = DINP; WT = (bf16_t*)(wl + W_IN); }
        else if ((r -= I_IN) < I_OUT) { W = p.in(7) + (size_t)l * 1024 * 1024; K = 1024; N = 1024; NP = 1024; WT = (bf16_t*)(wl + W_OUT); }
        else if ((r -= I_OUT) < I_KV) { W = p.in(21) + (size_t)l * 1024 * 2048; K = 1024; N = 2048; NP = 2048; WT = (bf16_t*)(wl + W_KV); }
        else { r -= I_KV; W = p.in(22) + (size_t)l * 1024 * 1024; K = 1024; N = 1024; NP = 1024; WT = (bf16_t*)(wl + W_O); }
        const int nblk = NP / 32, kb = r / nblk, nb = r % nblk, n0 = nb * 32;
        int orow = n0;
        if (gu) { const int f = (n0 < 2816) ? n0 : n0 - 2816; orow = (f >> 7) * 256 + (f & 127) + ((n0 < 2816) ? 0 : 128); }
        transpose_item(W, K, N, WT, orow, kb * 64, n0, scr, lane);
    }
    const int gt = blockIdx.x * 512 + tid, NGT = gridDim.x * 512;
    for (int i = gt; i < NL * 1024 * 1024 / 4; i += NGT) {
        const int l = i / (1024 * 1024 / 4), e = i % (1024 * 1024 / 4);
        const f32x4 v = ((const f32x4*)(p.in(20) + (size_t)l * 1024 * 1024))[e];
        u32x2 o; o.x = pk2(v.x, v.y); o.y = pk2(v.z, v.w);
        ((u32x2*)(p.ws() + WS_W + (size_t)l * LAYER_W + W_Q))[e] = o;
    }
    float* rc = (float*)(p.ws() + WS_ROPE); float* rs = rc + 4096 * 32;
    for (int i = gt; i < 4096 * 32; i += NGT) {
        const int s = i >> 5, d = i & 31;
        const float ang = (float)s * p.invf(d);
        const float n = rintf(ang * 0.15915494309189535f);
        float r = fmaf(-n, 6.2831854820251465f, ang); r = fmaf(-n, -1.7484555e-07f, r);
        rc[i] = cosf(r); rs[i] = sinf(r);
    }
    for (int m = gw; m < NL * 4096; m += NGW) { const int l = m >> 12, rr = m & 4095;
        rms_row(p.in(1) + (size_t)rr * 1024, p.in(19) + l * 1024, (bf16_t*)(p.ws() + WS_MEMN) + (size_t)m * 1024, nullptr, lane); }
}

__device__ __forceinline__ void phase_norm(const Ctx p, const float* src, const float* gain, float* copy) {
    const int tid_ = opaque_tid(), lane = tid_ & 63, wave = tid_ >> 6;
    const int gw = blockIdx.x * 8 + wave, NGW = gridDim.x * 8;
    bf16_t* hn = (bf16_t*)(p.ws() + WS_HN);
    for (int m = gw; m < TT; m += NGW) rms_row(src + (size_t)m * 1024, gain, hn + (size_t)m * 1024, copy ? copy + (size_t)m * 1024 : nullptr, lane);
}

__device__ __forceinline__ void phase_final(const Ctx p) {
    const int tid_ = opaque_tid(), lane = tid_ & 63, wave = tid_ >> 6;
    const int gw = blockIdx.x * 8 + wave, NGW = gridDim.x * 8;
    const f32x4* gr = (const f32x4*)p.in(26) + lane;
    for (int m = gw; m < TT; m += NGW) {
        f32x4* xr = (f32x4*)(p.out() + (size_t)m * 1024) + lane;
        f32x4 v[4]; float s = 0.f;
#pragma unroll
        for (int j = 0; j < 4; ++j) { v[j] = xr[64 * j]; s += (v[j].x * v[j].x + v[j].y * v[j].y) + (v[j].z * v[j].z + v[j].w * v[j].w); }
        const float rstd = rsqrtf(wave_sum(s) * (1.f / 1024.f) + EPS);
#pragma unroll
        for (int j = 0; j < 4; ++j) xr[64 * j] = v[j] * rstd * gr[64 * j];
    }
}

__device__ __forceinline__ void phase_softmax(const Ctx p) {
    const int tid_ = opaque_tid(), lane = tid_ & 63, wave = tid_ >> 6;
    const int gw = blockIdx.x * 8 + wave, NGW = gridDim.x * 8;
    bf16_t* S = (bf16_t*)(p.ws() + WS_PROJ);
    for (int m = gw; m < TT; m += NGW) {
        u32x4* rp = (u32x4*)(S + (size_t)m * 1024) + lane * 2;
        const u32x4 w0 = rp[0], w1 = rp[1];
        float v[16];
        v[0] = bflo(w0.x); v[1] = bfhi(w0.x); v[2] = bflo(w0.y); v[3] = bfhi(w0.y); v[4] = bflo(w0.z); v[5] = bfhi(w0.z); v[6] = bflo(w0.w); v[7] = bfhi(w0.w);
        v[8] = bflo(w1.x); v[9] = bfhi(w1.x); v[10] = bflo(w1.y); v[11] = bfhi(w1.y); v[12] = bflo(w1.z); v[13] = bfhi(w1.z); v[14] = bflo(w1.w); v[15] = bfhi(w1.w);
        float mx = v[0];
#pragma unroll
        for (int i = 1; i < 16; ++i) mx = fmaxf(mx, v[i]);
#pragma unroll
        for (int o = 1; o < 16; o <<= 1) mx = fmaxf(mx, __shfl_xor(mx, o));
        float sum = 0.f;
#pragma unroll
        for (int i = 0; i < 16; ++i) { v[i] = __expf(v[i] - mx); sum += v[i]; }
#pragma unroll
        for (int o = 1; o < 16; o <<= 1) sum += __shfl_xor(sum, o);
        const float inv = 1.0f / sum;
        u32x4 o0, o1;
        o0.x = pk2(v[0] * inv, v[1] * inv); o0.y = pk2(v[2] * inv, v[3] * inv); o0.z = pk2(v[4] * inv, v[5] * inv); o0.w = pk2(v[6] * inv, v[7] * inv);
        o1.x = pk2(v[8] * inv, v[9] * inv); o1.y = pk2(v[10] * inv, v[11] * inv); o1.z = pk2(v[12] * inv, v[13] * inv); o1.w = pk2(v[14] * inv, v[15] * inv);
        rp[0] = o0; rp[1] = o1;
    }
}

constexpr int PQ = 68;
constexpr int PB = 72;
constexpr int ARRB = 64 * PB * 2;
constexpr int M_QP = 0, M_QN = M_QP + ARRB, M_KN = M_QN + ARRB, M_KP = M_KN + ARRB, M_KNT = M_KP + ARRB, M_VT = M_KNT + ARRB, M_SC = M_VT + ARRB, M_STT = M_SC + ARRB,
              M_G = M_STT + ARRB, M_SEG = M_G + 64 * PQ * 4, M_CL = M_SEG + 8 * 64 * 4, M_RF = M_CL + 256, M_W2 = M_RF + 256, M_BA = M_W2 + 2048, M_END = M_BA + 128;
static_assert(M_END <= PARAM_OFF, "mixer LDS");
#define LBAR() do { asm volatile("s_waitcnt lgkmcnt(0)" ::: "memory"); __builtin_amdgcn_s_barrier(); asm volatile("" ::: "memory"); } while (0)

__device__ __forceinline__ void unpack8(const u32x4 w, float (&f)[8]) {
    f[0] = bflo(w.x); f[1] = bfhi(w.x); f[2] = bflo(w.y); f[3] = bfhi(w.y); f[4] = bflo(w.z); f[5] = bfhi(w.z); f[6] = bflo(w.w); f[7] = bfhi(w.w);
}
__device__ __forceinline__ bf16x8 ldfrag(LAS unsigned char* arr, int r0, int k0, int lane) {
    return *(const LAS bf16x8*)(arr + (((r0 + (lane & 15)) * PB + k0 + ((lane >> 4) << 3)) << 1));
}
__device__ __forceinline__ void st4bf(LAS unsigned char* arr, int r, int c, float a, float b, float c2, float d) {
    u32x2 w; w.x = pk2(a, b); w.y = pk2(c2, d); *(LAS u32x2*)(arr + ((r * PB + c) << 1)) = w;
}
__device__ __forceinline__ void st1bf(LAS unsigned char* arr, int r, int c, float a) { *(LAS unsigned short*)(arr + ((r * PB + c) << 1)) = (unsigned short)f2bf(a); }
#define MFMA16(a, b, c) __builtin_amdgcn_mfma_f32_16x16x32_bf16((a), (b), (c), 0, 0, 0)

template <int MIX>
__device__ __forceinline__ void mix_load(const bf16_t* pr, const float* rope, int h, int cgp, u32x4& r0, u32x4& r1, u32x4& r2, u32x4& r3, u32x4& rv) {
    if constexpr (MIX == 0) {
        rv = *(const u32x4*)(pr + 512 + h * 64 + cgp * 8);
        const u32x2 a = *(const u32x2*)(pr + h * 64 + 4 * cgp), b = *(const u32x2*)(pr + h * 64 + 32 + 4 * cgp);
        const u32x2 c = *(const u32x2*)(pr + 256 + h * 64 + 4 * cgp), d = *(const u32x2*)(pr + 256 + h * 64 + 32 + 4 * cgp);
        r0 = (u32x4){a.x, a.y, b.x, b.y}; r1 = (u32x4){c.x, c.y, d.x, d.y};
        r2 = *(const u32x4*)(rope + 4 * cgp); r3 = *(const u32x4*)(rope + 4096 * 32 + 4 * cgp);
    } else if constexpr (MIX == 2) {
        rv = *(const u32x4*)(pr + 1792 + h * 64 + cgp * 8);
        const u32x2 a = *(const u32x2*)(pr + 1536 + h * 32 + 4 * cgp), b = *(const u32x2*)(pr + 1664 + h * 32 + 4 * cgp);
        r0 = (u32x4){a.x, a.y, b.x, b.y}; r1 = *(const u32x4*)(pr + 2048); r2 = *(const u32x4*)(pr + 2056); r3 = r2;
    } else {
        rv = *(const u32x4*)(pr + 2832 + h * 64 + cgp * 8);
        r0 = *(const u32x4*)(pr + 2320 + h * 64 + 8 * cgp); r1 = *(const u32x4*)(pr + 2576 + h * 64 + 8 * cgp); r2 = r1; r3 = r1;
    }
}

template <int MIX>
__device__ __forceinline__ void gla_chain(const Ctx p, int l, int b, int h, LAS unsigned char* lds) {
    constexpr int DK = (MIX == 2) ? 32 : 64;
    constexpr bool CAUSAL = (MIX == 3);
    constexpr int NE = DK / 8, NG = NE / 4, KS = DK / 32;
    constexpr int GOFF = MIX == 0 ? 768 : (MIX == 2 ? 2064 : 3088);
    constexpr int YOFF = MIX == 0 ? 0 : (MIX == 2 ? 512 : 768);
    const int tid = opaque_tid(), lane = tid & 63, w = __builtin_amdgcn_readfirstlane(tid >> 6), row = tid >> 3, cgp = tid & 7, quad = lane >> 4, l15 = lane & 15;
    LAS unsigned char* QP = lds + M_QP; LAS unsigned char* QN = lds + M_QN; LAS unsigned char* KN = lds + M_KN; LAS unsigned char* KP = lds + M_KP;
    LAS unsigned char* KNT = lds + M_KNT; LAS unsigned char* VT = lds + M_VT; LAS unsigned char* SC = lds + M_SC; LAS unsigned char* STT = lds + M_STT;
    LAS float* G = (LAS float*)(lds + M_G); LAS float* SEG = (LAS float*)(lds + M_SEG); LAS float* CL = (LAS float*)(lds + M_CL); LAS float* RF = (LAS float*)(lds + M_RF);
    LAS float* W2 = (LAS float*)(lds + M_W2); LAS float* BA = (LAS float*)(lds + M_BA);
    const bf16_t* proj = (const bf16_t*)(p.ws() + WS_PROJ) + (size_t)b * SEQ * DINP;
    bf16_t* Y = (bf16_t*)(p.ws() + WS_HN) + (size_t)b * SEQ * 1024;
    const float* rope = (const float*)(p.ws() + WS_ROPE);
    const int gb0 = (MIX == 3) ? 8 * cgp : 4 * cgp, gb1 = (MIX == 0) ? 32 + 4 * cgp : 8 * cgp + 4;
    f32x4 S[4];
#pragma unroll
    for (int i = 0; i < 4; ++i) S[i] = (f32x4){0.f, 0.f, 0.f, 0.f};
    float lbv[8];
#pragma unroll
    for (int i = 0; i < 8; ++i) lbv[i] = 0.f;
    float lg = 0.f;
    if constexpr (MIX == 0) lg = log1pf(-exp2f(-5.0f - (float)h));
    LBAR();
    if constexpr (MIX == 2) {
        const float* w2 = p.in(15) + (size_t)l * 16 * 128; const float* ba = p.in(16) + (size_t)l * 128;
        { const int r = tid >> 5, d = tid & 31; W2[r * 32 + d] = w2[r * 128 + h * 32 + d]; }
        if (tid < 32) BA[tid] = ba[h * 32 + tid];
    }
    if constexpr (MIX == 3) {
        const float* lg4 = p.in(17);
#pragma unroll
        for (int i = 0; i < 8; ++i) { const int ch = h * 64 + cgp * 8 + i;
            const float a0 = lg4[ch], a1 = lg4[256 + ch], a2 = lg4[512 + ch], a3 = lg4[768 + ch];
            const float mx = fmaxf(fmaxf(a0, a1), fmaxf(a2, a3));
            const float e0 = expf(a0 - mx), e1 = expf(a1 - mx), e2 = expf(a2 - mx), e3 = expf(a3 - mx);
            const float inv = 1.0f / (e0 + e1 + e2 + e3);
            float lb = 0.f; if (l >= 1) lb += e1 * inv; if (l >= 2) lb += e2 * inv; if (l >= 3) lb += e3 * inv;
            lbv[i] = lb; }
    }
    u32x4 r0, r1, r2, r3, rv;
    mix_load<MIX>(proj + (size_t)row * DINP, rope + (size_t)row * 32, h, cgp, r0, r1, r2, r3, rv);
    for (int c = 0; c < 64; ++c) {
        LBAR();
        const int t0 = c * 64;
        u32x2 gt[4];
        if (w < 4) {
#pragma unroll
            for (int et = 0; et < 4; ++et) gt[et] = *(const u32x2*)(proj + (size_t)(t0 + 16 * w + l15) * DINP + GOFF + h * 64 + 16 * et + 4 * quad);
        }
        float q[NE], k[NE], g[NE];
        { float vv[8]; unpack8(rv, vv);
#pragma unroll
          for (int i = 0; i < 8; ++i) st1bf(VT, cgp * 8 + i, row, vv[i]); }
        if constexpr (MIX == 0) {
            const float q1[4] = {bflo(r0.x), bfhi(r0.x), bflo(r0.y), bfhi(r0.y)}, q2[4] = {bflo(r0.z), bfhi(r0.z), bflo(r0.w), bfhi(r0.w)};
            const float k1[4] = {bflo(r1.x), bfhi(r1.x), bflo(r1.y), bfhi(r1.y)}, k2[4] = {bflo(r1.z), bfhi(r1.z), bflo(r1.w), bfhi(r1.w)};
            const float cs[4] = {__uint_as_float(r2.x), __uint_as_float(r2.y), __uint_as_float(r2.z), __uint_as_float(r2.w)};
            const float sn[4] = {__uint_as_float(r3.x), __uint_as_float(r3.y), __uint_as_float(r3.z), __uint_as_float(r3.w)};
#pragma unroll
            for (int i = 0; i < 4; ++i) { q[i] = q1[i] * cs[i] - q2[i] * sn[i]; q[4 + i] = q1[i] * sn[i] + q2[i] * cs[i];
                k[i] = (k1[i] * cs[i] - k2[i] * sn[i]) * 0.125f; k[4 + i] = (k1[i] * sn[i] + k2[i] * cs[i]) * 0.125f; g[i] = lg; g[4 + i] = lg; }
        } else if constexpr (MIX == 2) {
            const float qq[4] = {bflo(r0.x), bfhi(r0.x), bflo(r0.y), bfhi(r0.y)}, kk[4] = {bflo(r0.z), bfhi(r0.z), bflo(r0.w), bfhi(r0.w)};
            float al[16];
            { float t8[8]; unpack8(r1, t8);
#pragma unroll
              for (int i = 0; i < 8; ++i) al[i] = t8[i];
              unpack8(r2, t8);
#pragma unroll
              for (int i = 0; i < 8; ++i) al[8 + i] = t8[i]; }
#pragma unroll
            for (int i = 0; i < 4; ++i) {
                float a = BA[gb0 + i];
#pragma unroll
                for (int r = 0; r < 16; ++r) a += al[r] * W2[r * 32 + gb0 + i];
                const float ls = -(fmaxf(-a, 0.f) + logf(1.0f + __expf(-fabsf(a))));
                q[i] = qq[i] * 0.17677669529663687f; k[i] = kk[i]; g[i] = ls * 0.0625f; }
        } else {
            float qq[8], ff[8]; unpack8(r0, qq); unpack8(r1, ff);
#pragma unroll
            for (int i = 0; i < 8; ++i) {
                const float sg = 1.0f / (1.0f + __expf(-ff[i])), nsg = 1.0f / (1.0f + __expf(ff[i]));
                q[i] = siluf_(qq[i]); k[i] = (1.0f - lbv[i]) * nsg; g[i] = logf(lbv[i] + (1.0f - lbv[i]) * sg); }
        }
#pragma unroll
        for (int gq = 0; gq < NG; ++gq) { const int db = gq ? gb1 : gb0; *(LAS f32x4*)(G + row * PQ + db) = (f32x4){g[4 * gq], g[4 * gq + 1], g[4 * gq + 2], g[4 * gq + 3]}; }
        if (c < 63) mix_load<MIX>(proj + (size_t)(t0 + 64 + row) * DINP, rope + (size_t)(t0 + 64 + row) * 32, h, cgp, r0, r1, r2, r3, rv);
        LBAR();
        const int seg = tid / DK, sd = tid % DK;
        if (tid < 8 * DK) { float cum = 0.f;
#pragma unroll
            for (int r = 0; r < 8; ++r) { cum += G[(8 * seg + r) * PQ + sd]; G[(8 * seg + r) * PQ + sd] = cum; }
            SEG[seg * 64 + sd] = cum; }
        LBAR();
        if (tid < 8 * DK) { float off = 0.f;
#pragma unroll
            for (int s = 0; s < 7; ++s) off += (s < seg) ? SEG[s * 64 + sd] : 0.f;
            float last = 0.f;
#pragma unroll
            for (int r = 0; r < 8; ++r) { last = G[(8 * seg + r) * PQ + sd] + off; G[(8 * seg + r) * PQ + sd] = last; }
            if (seg == 3) RF[sd] = last;
            if (seg == 7) CL[sd] = last; }
        LBAR();
#pragma unroll
        for (int gq = 0; gq < NG; ++gq) { const int db = gq ? gb1 : gb0;
            const f32x4 cv = *(const LAS f32x4*)(G + row * PQ + db), rf = *(const LAS f32x4*)(RF + db);
            float e1[4], e2[4];
#pragma unroll
            for (int i = 0; i < 4; ++i) { e1[i] = __expf(cv[i] - rf[i]); e2[i] = __expf(rf[i] - cv[i]); }
            st4bf(QP, row, db, q[4 * gq] * e1[0], q[4 * gq + 1] * e1[1], q[4 * gq + 2] * e1[2], q[4 * gq + 3] * e1[3]);
            st4bf(KN, row, db, k[4 * gq] * e2[0], k[4 * gq + 1] * e2[1], k[4 * gq + 2] * e2[2], k[4 * gq + 3] * e2[3]);
#pragma unroll
            for (int i = 0; i < 4; ++i) st1bf(KNT, db + i, row, k[4 * gq + i] * e2[i]);
            if constexpr (!CAUSAL) {
                st4bf(QN, row, db, q[4 * gq] * e2[0], q[4 * gq + 1] * e2[1], q[4 * gq + 2] * e2[2], q[4 * gq + 3] * e2[3]);
                st4bf(KP, row, db, k[4 * gq] * e1[0], k[4 * gq + 1] * e1[1], k[4 * gq + 2] * e1[2], k[4 * gq + 3] * e1[3]); } }
        if (w >= 4 && (w - 4) < DK / 16) { const int dd = 16 * (w - 4) + 4 * quad; const f32x4 rf = *(const LAS f32x4*)(RF + dd);
            const float x0 = __expf(rf[0]), x1 = __expf(rf[1]), x2 = __expf(rf[2]), x3 = __expf(rf[3]);
#pragma unroll
            for (int et = 0; et < 4; ++et) st4bf(STT, 16 * et + l15, dd, x0 * S[et][0], x1 * S[et][1], x2 * S[et][2], x3 * S[et][3]); }
        LBAR();
        {
            const int j0 = 16 * (w >> 1);
            bf16x8 bqp[KS], bqn[KS];
#pragma unroll
            for (int ks = 0; ks < KS; ++ks) { bqp[ks] = ldfrag(QP, j0, 32 * ks, lane); if constexpr (!CAUSAL) bqn[ks] = ldfrag(QN, j0, 32 * ks, lane); else bqn[ks] = bqp[ks]; }
#pragma unroll
            for (int tc = 0; tc < 2; ++tc) { const int m0 = 16 * (2 * (w & 1) + tc);
                f32x4 lo = (f32x4){0.f, 0.f, 0.f, 0.f}, up = lo;
#pragma unroll
                for (int ks = 0; ks < KS; ++ks) { lo = MFMA16(ldfrag(KN, m0, 32 * ks, lane), bqp[ks], lo);
                    if constexpr (!CAUSAL) up = MFMA16(ldfrag(KP, m0, 32 * ks, lane), bqn[ks], up); }
                const int j = j0 + l15, m = m0 + 4 * quad;
                float v[4];
#pragma unroll
                for (int i = 0; i < 4; ++i) v[i] = (m + i <= j) ? lo[i] : (CAUSAL ? 0.f : up[i]);
                st4bf(SC, j, m, v[0], v[1], v[2], v[3]); }
        }
        LBAR();
        if (w < 4) {
            const int j0 = 16 * w;
            bf16x8 bsc[2], bq[KS];
            bsc[0] = ldfrag(SC, j0, 0, lane); bsc[1] = ldfrag(SC, j0, 32, lane);
#pragma unroll
            for (int ks = 0; ks < KS; ++ks) bq[ks] = ldfrag(QP, j0, 32 * ks, lane);
            f32x4 o[4];
#pragma unroll
            for (int et = 0; et < 4; ++et) { f32x4 a = (f32x4){0.f, 0.f, 0.f, 0.f};
                a = MFMA16(ldfrag(VT, 16 * et, 0, lane), bsc[0], a); a = MFMA16(ldfrag(VT, 16 * et, 32, lane), bsc[1], a);
#pragma unroll
                for (int ks = 0; ks < KS; ++ks) a = MFMA16(ldfrag(STT, 16 * et, 32 * ks, lane), bq[ks], a);
                o[et] = a; }
            float s = 0.f;
#pragma unroll
            for (int et = 0; et < 4; ++et) s += (o[et][0] + o[et][1]) + (o[et][2] + o[et][3]);
            s += __shfl_xor(s, 16); s += __shfl_xor(s, 32);
            const float mu = s * (1.0f / 64.0f);
            float qv = 0.f;
#pragma unroll
            for (int et = 0; et < 4; ++et) { o[et] = o[et] - mu; qv += (o[et][0] * o[et][0] + o[et][1] * o[et][1]) + (o[et][2] * o[et][2] + o[et][3] * o[et][3]); }
            qv += __shfl_xor(qv, 16); qv += __shfl_xor(qv, 32);
            const float rstd = rsqrtf(qv * (1.0f / 64.0f) + EPS);
            bf16_t* yr = Y + (size_t)(t0 + j0 + l15) * 1024 + YOFF + h * 64 + 4 * quad;
#pragma unroll
            for (int et = 0; et < 4; ++et) { const float g0 = bflo(gt[et].x), g1 = bfhi(gt[et].x), g2 = bflo(gt[et].y), g3 = bfhi(gt[et].y);
                u32x2 wv; wv.x = pk2(siluf_(g0) * o[et][0] * rstd, siluf_(g1) * o[et][1] * rstd); wv.y = pk2(siluf_(g2) * o[et][2] * rstd, siluf_(g3) * o[et][3] * rstd);
                *(u32x2*)(yr + 16 * et) = wv; }
        } else if ((w - 4) < DK / 16) {
            const int d0 = 16 * (w - 4);
            const bf16x8 a0 = ldfrag(KNT, d0, 0, lane), a1 = ldfrag(KNT, d0, 32, lane);
            const f32x4 cl = *(const LAS f32x4*)(CL + d0 + 4 * quad), rf = *(const LAS f32x4*)(RF + d0 + 4 * quad);
            f32x4 ec, ef;
#pragma unroll
            for (int i = 0; i < 4; ++i) { ec[i] = __expf(cl[i]); ef[i] = __expf(cl[i] - rf[i]); }
#pragma unroll
            for (int et = 0; et < 4; ++et) { f32x4 a = (f32x4){0.f, 0.f, 0.f, 0.f};
                a = MFMA16(a0, ldfrag(VT, 16 * et, 0, lane), a); a = MFMA16(a1, ldfrag(VT, 16 * et, 32, lane), a);
                S[et] = ec * S[et] + ef * a; }
        }
    }
    LBAR();
}

constexpr int R_XB = 0, R_XCF = 17408, R_XCB = R_XCF + 64 * PQ * 4, R_WAT = R_XCB + ARRB, R_WXT = R_WAT + ARRB, R_AA = R_WXT + ARRB, R_UU = R_AA + 16384, R_CW = R_UU + 16384,
              R_CB = R_CW + 1024, R_BA = R_CB + 256, R_BX = R_BA + 256, R_LS = R_BX + 256, R_END = R_LS + 256;
static_assert(R_END <= PARAM_OFF, "lru LDS");

__device__ __forceinline__ void lru_chain(const Ctx p, int l, int b, int n, LAS unsigned char* lds) {
    const int tid = opaque_tid(), lane = tid & 63, w = __builtin_amdgcn_readfirstlane(tid >> 6), row = tid >> 3, cgp = tid & 7, quad = lane >> 4, l15 = lane & 15;
    LAS float* XB = (LAS float*)(lds + R_XB); LAS float* XCF = (LAS float*)(lds + R_XCF); LAS unsigned char* XCB = lds + R_XCB; LAS unsigned char* WAT = lds + R_WAT; LAS unsigned char* WXT = lds + R_WXT;
    LAS float* AA = (LAS float*)(lds + R_AA); LAS float* UU = (LAS float*)(lds + R_UU); LAS float* CW = (LAS float*)(lds + R_CW); LAS float* CB = (LAS float*)(lds + R_CB);
    LAS float* BAv = (LAS float*)(lds + R_BA); LAS float* BXv = (LAS float*)(lds + R_BX); LAS float* LS = (LAS float*)(lds + R_LS);
    const bf16_t* proj = (const bf16_t*)(p.ws() + WS_PROJ) + (size_t)b * SEQ * DINP;
    bf16_t* Y = (bf16_t*)(p.ws() + WS_HN) + (size_t)b * SEQ * 1024;
    LBAR();
    { const float* wa = p.in(10) + ((size_t)l * 4 + n) * 4096; const float* wx = p.in(12) + ((size_t)l * 4 + n) * 4096;
#pragma unroll
      for (int i = 0; i < 8; ++i) { const int idx = tid + 512 * i, d = idx >> 6, e = idx & 63; st1bf(WAT, e, d, wa[idx]); st1bf(WXT, e, d, wx[idx]); }
      if (tid < 256) CW[tid] = p.in(8)[(size_t)l * 1024 + (tid >> 6) * 256 + n * 64 + (tid & 63)];
      if (tid < 64) { const int ch = n * 64 + tid; CB[tid] = p.in(9)[(size_t)l * 256 + ch]; BAv[tid] = p.in(11)[(size_t)l * 256 + ch]; BXv[tid] = p.in(13)[(size_t)l * 256 + ch];
          const float lam = p.in(14)[(size_t)l * 256 + ch]; LS[tid] = -8.0f * (fmaxf(-lam, 0.f) + log1pf(expf(-fabsf(lam)))); }
      if (tid < 192) XB[tid] = 0.f; }
    float hreg = 0.f;
    u32x4 xr = *(const u32x4*)(proj + (size_t)row * DINP + 1024 + n * 64 + cgp * 8);
    for (int c = 0; c < 64; ++c) {
        LBAR();
        const int t0 = c * 64;
        const u32x4 gr = *(const u32x4*)(proj + (size_t)(t0 + row) * DINP + 1280 + n * 64 + cgp * 8);
        float xv[8]; unpack8(xr, xv);
#pragma unroll
        for (int i = 0; i < 8; ++i) XB[(row + 3) * 64 + cgp * 8 + i] = xv[i];
        if (c < 63) xr = *(const u32x4*)(proj + (size_t)(t0 + 64 + row) * DINP + 1024 + n * 64 + cgp * 8);
        LBAR();
        { float xc[8];
#pragma unroll
          for (int i = 0; i < 8; ++i) { const int ch = cgp * 8 + i;
              xc[i] = CB[ch] + CW[ch] * XB[row * 64 + ch] + CW[64 + ch] * XB[(row + 1) * 64 + ch] + CW[128 + ch] * XB[(row + 2) * 64 + ch] + CW[192 + ch] * XB[(row + 3) * 64 + ch]; }
          *(LAS f32x4*)(XCF + row * PQ + cgp * 8) = (f32x4){xc[0], xc[1], xc[2], xc[3]}; *(LAS f32x4*)(XCF + row * PQ + cgp * 8 + 4) = (f32x4){xc[4], xc[5], xc[6], xc[7]};
          u32x4 wv; wv.x = pk2(xc[0], xc[1]); wv.y = pk2(xc[2], xc[3]); wv.z = pk2(xc[4], xc[5]); wv.w = pk2(xc[6], xc[7]);
          *(LAS u32x4*)(XCB + ((row * PB + cgp * 8) << 1)) = wv; }
        LBAR();
        if (row >= 61) {
#pragma unroll
            for (int i = 0; i < 8; ++i) XB[(row - 61) * 64 + cgp * 8 + i] = xv[i]; }
        {
            const int tt = 16 * (w >> 1);
            const bf16x8 b0 = ldfrag(XCB, tt, 0, lane), b1 = ldfrag(XCB, tt, 32, lane);
#pragma unroll
            for (int tc = 0; tc < 2; ++tc) { const int e0 = 16 * (2 * (w & 1) + tc);
                f32x4 ar = (f32x4){0.f, 0.f, 0.f, 0.f}, ai = ar;
                ar = MFMA16(ldfrag(WAT, e0, 0, lane), b0, ar); ar = MFMA16(ldfrag(WAT, e0, 32, lane), b1, ar);
                ai = MFMA16(ldfrag(WXT, e0, 0, lane), b0, ai); ai = MFMA16(ldfrag(WXT, e0, 32, lane), b1, ai);
                const int t = tt + l15, e4 = e0 + 4 * quad;
                const f32x4 ba = *(const LAS f32x4*)(BAv + e4), bx = *(const LAS f32x4*)(BXv + e4), ls = *(const LAS f32x4*)(LS + e4), xc = *(const LAS f32x4*)(XCF + t * PQ + e4);
                f32x4 av, uv;
#pragma unroll
                for (int i = 0; i < 4; ++i) { const float r = sigmoidf_(ar[i] + ba[i]), ig = sigmoidf_(ai[i] + bx[i]);
                    const float la = r * ls[i]; av[i] = __expf(la); uv[i] = sqrtf(-expm1f(2.0f * la)) * (ig * xc[i]); }
                *(LAS f32x4*)(AA + t * 64 + e4) = av; *(LAS f32x4*)(UU + t * 64 + e4) = uv; }
        }
        LBAR();
        if (tid < 64) {
#pragma unroll 16
            for (int t = 0; t < 64; ++t) { hreg = AA[t * 64 + tid] * hreg + UU[t * 64 + tid]; UU[t * 64 + tid] = hreg; } }
        LBAR();
        { float gv[8]; unpack8(gr, gv);
          float o[8];
#pragma unroll
          for (int i = 0; i < 8; ++i) { const float x = gv[i], z = 0.7978845608028654f * (x + 0.044715f * x * x * x);
              const float th = 1.0f - 2.0f / (1.0f + __expf(2.0f * z)); o[i] = UU[row * 64 + cgp * 8 + i] * 0.5f * x * (1.0f + th); }
          u32x4 wv; wv.x = pk2(o[0], o[1]); wv.y = pk2(o[2], o[3]); wv.z = pk2(o[4], o[5]); wv.w = pk2(o[6], o[7]);
          *(u32x4*)(Y + (size_t)(t0 + row) * 1024 + 256 + n * 64 + cgp * 8) = wv; }
    }
    LBAR();
}

__device__ __forceinline__ void phase_mix(const Ctx p, int l, LAS unsigned char* lds) {
    LAS unsigned char* sm = lds;
    for (int cid = blockIdx.x; cid < 256; cid += gridDim.x) {
        const int mixer = cid & 3, w = cid >> 2, b = w >> 2, h = w & 3;
        if (mixer == 0) gla_chain<0>(p, l, b, h, sm);
        else if (mixer == 1) lru_chain(p, l, b, h, sm);
        else if (mixer == 2) gla_chain<2>(p, l, b, h, sm);
        else gla_chain<3>(p, l, b, h, sm);
    }
}

enum { T_PREP = 0, T_NORM, T_GBF, T_GSWI, T_GRES, T_MIX, T_SOFTMAX, T_FINAL };
constexpr int NSTEPS = 2 + 16 * NL + 1;
__host__ __device__ __forceinline__ void decode_step(int st, int& type, int& l, int& sub, bool& sync) {
    sync = true; l = 0; sub = 0;
    if (st == 0) { type = T_PREP; return; }
    if (st == 1) { type = T_GBF; sub = 0; return; }
    if (st == NSTEPS - 1) { type = T_FINAL; return; }
    const int r = (st - 2) & 15; l = (st - 2) >> 4;
    switch (r) {
        case 0: type = T_NORM; sub = 0; break;
        case 1: type = T_GSWI; sub = 0; break;
        case 2: type = T_GRES; sub = 0; break;
        case 3: type = T_NORM; sub = 1; break;
        case 4: type = T_GBF; sub = 1; break;
        case 5: type = T_MIX; break;
        case 6: type = T_GRES; sub = 1; break;
        case 7: type = T_NORM; sub = 2; sync = false; break;
        case 8: type = T_GBF; sub = 2; sync = false; break;
        case 9: type = T_GBF; sub = 3; break;
        case 10: type = T_GBF; sub = 4; break;
        case 11: type = T_SOFTMAX; break;
        case 12: type = T_GRES; sub = 2; break;
        case 13: type = T_NORM; sub = 3; break;
        case 14: type = T_GSWI; sub = 1; break;
        default: type = T_GRES; sub = 3; break;
    }
}

__global__ void __launch_bounds__(512, 2) fwd_kernel(Params pk) {
    extern __shared__ __attribute__((aligned(16))) unsigned char lds_raw[];
    LAS unsigned char* lds = (LAS unsigned char*)lds_raw;
    { const unsigned* ka = (const unsigned*)__builtin_amdgcn_kernarg_segment_ptr();
      if (threadIdx.x < sizeof(Params) / 4) ((LAS unsigned*)(lds + PARAM_OFF))[threadIdx.x] = ka[threadIdx.x]; }
    __syncthreads();
    Ctx p; p.lds = lds;
    const int G = gridDim.x, c = blockIdx.x;
    const int st_hi = p.hi();
    for (int st = p.lo(); st < st_hi; ++st) {
        unsigned char* ws = p.ws();
        int type, l, sub; bool sync;
        decode_step(st, type, l, sub, sync);
        const char* wl = (const char*)(ws + WS_W + (size_t)l * LAYER_W);
        if (type == T_PREP) phase_prep(p, lds);
        else if (type == T_NORM) {
            const float* gain = (sub == 0 ? p.in(2) : sub == 1 ? p.in(5) : sub == 2 ? p.in(18) : p.in(23)) + (size_t)l * 1024;
            const bool first = (l == 0 && sub == 0);
            for (int rep = 0; rep < REP_NORM; ++rep) phase_norm(p, first ? p.in(0) : p.out(), gain, first ? p.out() : nullptr);
        } else if (type == T_GBF) {
            pg8::Gemm g; pg8::Sched S; pg8::EpiBf16 E; S.G = G; S.c = c; S.bB = 0; E.sc = 1.0f; S.nM = 1; S.nN = 1;
            if (sub == 0) { g = {(const char*)(ws + WS_MEMN), (const char*)(ws + WS_W + W_KV), 1024, 1024, 1024}; S.kind = 2; S.nwg = 512; S.tA = 256 * 1024 * 2; S.tB = 256 * 1024 * 2; S.ldc = 2048; S.cw = 256; E.O = (bf16_t*)(ws + WS_KV); E.ldc = 2048; }
            else if (sub == 1) { g = {(const char*)(ws + WS_HN), wl + W_IN, 1024, 1024, 1024}; S.kind = 0; S.nM = 256; S.nN = 14; S.nwg = 256 * 14; S.tA = 256 * 1024 * 2; S.tB = 256 * 1024 * 2; S.ldc = DINP; S.cw = 256; E.O = (bf16_t*)(ws + WS_PROJ); E.ldc = DINP; }
            else if (sub == 2) { g = {(const char*)(ws + WS_KV + (size_t)l * 4096 * 2048 * 2), wl + W_Q, 2048, 1024, 256}; S.kind = 3; S.nwg = 256; S.tA = 0; S.tB = 0; S.ldc = 1024; S.cw = 256; E.O = (bf16_t*)(ws + WS_XM); E.ldc = 1024; }
            else if (sub == 3) { g = {wl + W_O, (const char*)(ws + WS_KV + (size_t)l * 4096 * 2048 * 2), 1024, 2048, 256}; S.kind = 4; S.nwg = 256; S.tA = 0; S.tB = 0; S.ldc = 1024; S.cw = 256; E.O = (bf16_t*)(ws + WS_XN); E.ldc = 1024; }
            else { g = {(const char*)(ws + WS_HN), (const char*)(ws + WS_XM), 1024, 1024, 1024}; S.kind = 1; S.nM = 256; S.nN = 4; S.nwg = 1024; S.tA = 256 * 1024 * 2; S.tB = 256 * 1024 * 2; S.bB = (size_t)1024 * 1024 * 2; S.ldc = 1024; S.cw = 256; E.O = (bf16_t*)(ws + WS_PROJ); E.ldc = 1024; E.sc = 0.0625f; }
            pg8::gemm_phase<pg8::EpiBf16>(lds, g, S, E);
        } else if (type == T_GSWI) {
            pg8::Gemm g = {(const char*)(ws + WS_HN), wl + (sub == 0 ? W_GU1 : W_GU2), 1024, 1024, 1024};
            pg8::Sched S; S.kind = 0; S.nM = 256; S.nN = 22; S.nwg = 256 * 22; S.G = G; S.c = c; S.ldc = FF; S.cw = 128; S.tA = 256 * 1024 * 2; S.tB = 256 * 1024 * 2; S.bB = 0;
            pg8::EpiSwi E; E.O = (bf16_t*)(ws + WS_PROJ); E.ldc = FF;
            pg8::gemm_phase<pg8::EpiSwi>(lds, g, S, E);
        } else if (type == T_GRES) {
            pg8::Gemm g; pg8::Sched S; pg8::EpiRes E; S.kind = 0; S.nM = 256; S.nN = 4; S.nwg = 1024; S.G = G; S.c = c; S.ldc = 1024; S.cw = 256; S.bB = 0; E.X = p.out(); E.sc = 1.0f;
            if (sub == 0 || sub == 3) { g = {(const char*)(ws + WS_PROJ), wl + (sub == 0 ? W_D1 : W_D2), FF, FF, FF}; S.tA = (size_t)256 * FF * 2; S.tB = (size_t)256 * FF * 2; E.sc = 0.5f; }
            else if (sub == 1) { g = {(const char*)(ws + WS_HN), wl + W_OUT, 1024, 1024, 1024}; S.tA = 256 * 1024 * 2; S.tB = 256 * 1024 * 2; }
            else { g = {(const char*)(ws + WS_PROJ), (const char*)(ws + WS_XN), 1024, 1024, 1024}; S.kind = 1; S.tA = 256 * 1024 * 2; S.tB = 256 * 1024 * 2; S.bB = (size_t)1024 * 1024 * 2; }
            pg8::gemm_phase<pg8::EpiRes>(lds, g, S, E);
        } else if (type == T_MIX) { for (int rep = 0; rep < REP_MIX; ++rep) phase_mix(p, l, lds); }
        else if (type == T_SOFTMAX) phase_softmax(p);
        else phase_final(p);
        if (sync && st + 1 < st_hi) { cg::this_grid().sync(); }
    }
}

extern "C" void kernel_launch(void* const* d_in, const int* in_sizes, int n_in, void* d_out, int out_size, void* d_ws, size_t ws_size, hipStream_t stream) {
    static int grid = 0;
    if (grid == 0) {
        if (n_in != 27 || out_size != TT * DM || ws_size < WS_END) { fprintf(stderr, "kernel_launch: unexpected shapes (n_in %d out %d ws %zu)\n", n_in, out_size, ws_size); grid = -1; return; }
        int dev = 0, cus = 0, per_cu = 0;
        hipGetDevice(&dev); hipDeviceGetAttribute(&cus, hipDeviceAttributeMultiprocessorCount, dev);
        hipFuncSetAttribute((const void*)fwd_kernel, hipFuncAttributeMaxDynamicSharedMemorySize, LDS_BYTES);
        hipOccupancyMaxActiveBlocksPerMultiprocessor(&per_cu, (const void*)fwd_kernel, 512, LDS_BYTES);
        if (per_cu < 1) per_cu = 1;
        grid = cus * per_cu;
        (void)hipGetLastError();
    }
    if (grid < 0) return;
    Params p{};
    for (int i = 0; i < 27; ++i) p.in[i] = (const float*)d_in[i];
    p.out = (float*)d_out; p.ws = (unsigned char*)d_ws;
    for (int d = 0; d < 32; ++d) p.inv_freq[d] = powf(10000.0f, -(float)d / 32.0f);
#if MK_ONE_LAUNCH
    p.lo = 0; p.hi = NSTEPS;
    void* args[] = {&p};
    hipError_t e = hipLaunchCooperativeKernel((const void*)fwd_kernel, dim3(grid), dim3(512), args, LDS_BYTES, stream);
    if (e != hipSuccess) fprintf(stderr, "cooperative launch failed: %s (grid %d)\n", hipGetErrorString(e), grid);
#else
    int lo = 0;
    for (int st = 0; st < NSTEPS; ++st) {
        int type, l, sub; bool sync; decode_step(st, type, l, sub, sync);
        if (sync || st == NSTEPS - 1) { p.lo = lo; p.hi = st + 1; hipLaunchKernelGGL(fwd_kernel, dim3(grid), dim3(512), LDS_BYTES, stream, p); lo = st + 1; }
    }
#endif
}
```

```cpp
#include <hip/hip_runtime.h>
#include <hip/hip_cooperative_groups.h>
#include <cstdio>
#include <cstdint>
#include <cmath>
namespace cg = cooperative_groups;

#ifndef REP_MIX
#define REP_MIX 1
#endif
#ifndef REP_PREP
#define REP_PREP 1
#endif
#ifndef REP_SYNC
#define REP_SYNC 1
#endif
#ifndef REP_GSWI
#define REP_GSWI 1
#endif
#ifndef REP_NORM
#define REP_NORM 1
#endif
#ifndef MK_ONE_LAUNCH
#define MK_ONE_LAUNCH 1
#endif

#define LAS __attribute__((address_space(3)))
typedef unsigned short bf16_t;
typedef short bf16x8 __attribute__((ext_vector_type(8)));
typedef float f32x4 __attribute__((ext_vector_type(4)));
typedef unsigned u32x4 __attribute__((ext_vector_type(4)));
typedef unsigned u32x2 __attribute__((ext_vector_type(2)));

constexpr int TT = 65536, DM = 1024, FF = 2816, DIN = 3344, DINP = 3584, NL = 4, SEQ = 4096;
constexpr float EPS = 1e-6f;
constexpr size_t MiB = 1u << 20;
constexpr size_t WS_ROPE = 1 * MiB;
constexpr size_t WS_W = 2 * MiB, LAYER_W = 50 * MiB;
constexpr size_t W_GU1 = 0, W_D1 = 11 * MiB, W_IN = W_D1 + 5632 * 1024, W_OUT = W_IN + 7 * MiB, W_Q = W_OUT + 2 * MiB, W_KV = W_Q + 2 * MiB,
                 W_O = W_KV + 4 * MiB, W_GU2 = W_O + 2 * MiB, W_D2 = W_GU2 + 11 * MiB;
static_assert(W_D2 + 5632 * 1024 == LAYER_W, "weight map");
constexpr size_t WS_MEMN = 202 * MiB;
constexpr size_t WS_KV = 234 * MiB;
constexpr size_t WS_HN = 298 * MiB;
constexpr size_t WS_PROJ = 426 * MiB;
constexpr size_t WS_XM = WS_PROJ + 128 * MiB;
constexpr size_t WS_XN = WS_PROJ + 160 * MiB;
constexpr size_t WS_END = 874 * MiB;

struct Params {
    const float* in[27];
    float* out; unsigned char* ws;
    float inv_freq[32];
    int lo, hi;
};


constexpr int LDS_BYTES = 147456;
constexpr int PARAM_OFF = LDS_BYTES - 1024;
struct Ctx {
    LAS unsigned char* lds;
    __device__ __forceinline__ unsigned long long q(int i) const { const LAS unsigned* pw = (const LAS unsigned*)(lds + PARAM_OFF) + 2 * i;
        const unsigned lo = __builtin_amdgcn_readfirstlane(pw[0]), hi = __builtin_amdgcn_readfirstlane(pw[1]); return ((unsigned long long)hi << 32) | lo; }
    __device__ __forceinline__ const float* in(int i) const { return (const float*)q(i); }
    __device__ __forceinline__ float* out() const { return (float*)q(27); }
    __device__ __forceinline__ unsigned char* ws() const { return (unsigned char*)q(28); }
    __device__ __forceinline__ float invf(int d) const { return ((const LAS float*)(lds + PARAM_OFF))[58 + d]; }
    __device__ __forceinline__ int lo() const { return __builtin_amdgcn_readfirstlane(((const LAS int*)(lds + PARAM_OFF))[90]); }
    __device__ __forceinline__ int hi() const { return __builtin_amdgcn_readfirstlane(((const LAS int*)(lds + PARAM_OFF))[91]); }
};
static_assert(sizeof(Params) == 368, "Params layout");

__device__ __forceinline__ int opaque_tid() { int t = threadIdx.x; asm volatile("" : "+v"(t)); return t; }
__device__ __forceinline__ unsigned f2bf(float f) { unsigned u = __float_as_uint(f); return (u + 0x7fffu + ((u >> 16) & 1u)) >> 16; }
__device__ __forceinline__ unsigned pk2(float lo, float hi) { return f2bf(lo) | (f2bf(hi) << 16); }
__device__ __forceinline__ float bflo(unsigned w) { return __uint_as_float(w << 16); }
__device__ __forceinline__ float bfhi(unsigned w) { return __uint_as_float(w & 0xffff0000u); }
__device__ __forceinline__ float sigmoidf_(float x) { return 1.0f / (1.0f + __expf(-x)); }
__device__ __forceinline__ float siluf_(float x) { return x / (1.0f + __expf(-x)); }
__device__ __forceinline__ float wave_sum(float v) {
#pragma unroll
    for (int o = 1; o < 64; o <<= 1) v += __shfl_xor(v, o);
    return v;
}

namespace pg8 {
constexpr int BM = 256, BK = 64, HALF = 128, HTB = HALF * BK * 2, STAGE_BYTES = 8 * HTB, NXCD = 8, WGM = 8;
__host__ __device__ __forceinline__ int lds_byte(int r, int c) { const int st = (r >> 4) * 2 + (c >> 5), rr = r & 15, cc = c & 31, ob = rr * 64 + cc * 2; return st * 1024 + (ob ^ (((ob >> 9) & 1) << 5)); }
__host__ __device__ __forceinline__ void stage_rc(int b, int& R, int& C) { const int st = b / 1024, sb = b % 1024, swz = sb ^ (((sb >> 9) & 1) << 5); R = (st >> 1) * 16 + swz / 64; C = (st & 1) * 32 + (swz % 64) / 2; }
__host__ __device__ __forceinline__ int perm32(int rho) { const int n = rho >> 4, i = rho & 15; return 8 * (i >> 2) + 4 * n + (i & 3); }

struct Unit { size_t offA, offB, offC; };
struct Gemm { const char* A; const char* Bt; int lda, ldb, K; };

struct Sched {
    int kind, nM, nN, nwg, G, c, ldc, cw;
    size_t tA, tB, bB;
    __device__ __forceinline__ bool next(int i, Unit& u) const {
        const long L = (long)i * G + c; if (L >= nwg) return false;
        if (kind <= 1) {
            int wgid = (int)L; { const int q = nwg / NXCD, r = nwg % NXCD, xcd = wgid % NXCD, off = wgid / NXCD; wgid = (xcd < r ? xcd * (q + 1) : r * (q + 1) + (xcd - r) * q) + off; }
            const int nig = WGM * nN, gid = wgid / nig, fm = gid * WGM, gsz = (nM - fm) < WGM ? (nM - fm) : WGM;
            const int pm = fm + ((wgid % nig) % gsz), pn = (wgid % nig) / gsz;
            u.offA = (size_t)pm * tA; u.offB = (size_t)pn * tB + (kind == 1 ? (size_t)(pm >> 4) * bB : (size_t)0); u.offC = (size_t)pm * 256 * ldc + (size_t)pn * cw;
        } else if (kind == 2) {
            const int ll = (int)L >> 7, r = (int)L & 127, pm = r >> 3, pn = r & 7;
            u.offA = (size_t)ll * (4096 * 1024 * 2) + (size_t)pm * tA; u.offB = (size_t)ll * LAYER_W + (size_t)pn * tB; u.offC = (size_t)ll * (4096 * 2048) + (size_t)pm * 256 * 2048 + (size_t)pn * 256;
        } else if (kind == 3) {
            const int z = (int)L >> 2, pn = (int)L & 3, b = z >> 2, h = z & 3;
            u.offA = ((size_t)(b * 256) * 2048 + h * 256) * 2; u.offB = ((size_t)pn * 256 * 1024 + h * 256) * 2; u.offC = (size_t)b * 1024 * 1024 + (size_t)(h * 256) * 1024 + pn * 256;
        } else {
            const int z = (int)L >> 2, pm = (int)L & 3, b = z >> 2, h = z & 3;
            u.offA = ((size_t)pm * 256 * 1024 + h * 256) * 2; u.offB = ((size_t)(b * 256) * 2048 + 1024 + h * 256) * 2; u.offC = (size_t)b * 1024 * 1024 + (size_t)(pm * 256) * 1024 + h * 256;
        }
        return true;
    }
};

__device__ __forceinline__ unsigned cvt_pk_bf16(float lo, float hi) { unsigned r; asm volatile("v_cvt_pk_bf16_f32 %0, %1, %2" : "=v"(r) : "v"(lo), "v"(hi)); return r; }

struct EpiBf16 {
    static constexpr bool PERM = true;
    bf16_t* O; int ldc; float sc;
    __device__ __forceinline__ void operator()(const f32x4 (&acc)[2][2][4][2], const Unit& u, int wr, int wc, int fr, int fq) const {
        bf16_t* base = O + u.offC + (size_t)(wr * 64 + fr) * ldc + wc * 32 + 8 * fq;
#pragma unroll
        for (int ai = 0; ai < 2; ++ai)
#pragma unroll
            for (int m = 0; m < 4; ++m) { bf16_t* rowp = base + (size_t)(ai * HALF + m * 16) * ldc;
#pragma unroll
                for (int bj = 0; bj < 2; ++bj) { const f32x4 v0 = acc[ai][bj][m][0] * sc, v1 = acc[ai][bj][m][1] * sc;
                    u32x4 w; w.x = cvt_pk_bf16(v0[0], v0[1]); w.y = cvt_pk_bf16(v0[2], v0[3]); w.z = cvt_pk_bf16(v1[0], v1[1]); w.w = cvt_pk_bf16(v1[2], v1[3]);
                    *(u32x4*)(rowp + bj * HALF) = w; } }
    }
};
struct EpiSwi {
    static constexpr bool PERM = true;
    bf16_t* O; int ldc;
    __device__ __forceinline__ void operator()(const f32x4 (&acc)[2][2][4][2], const Unit& u, int wr, int wc, int fr, int fq) const {
        bf16_t* base = O + u.offC + (size_t)(wr * 64 + fr) * ldc + wc * 32 + 8 * fq;
#pragma unroll
        for (int ai = 0; ai < 2; ++ai)
#pragma unroll
            for (int m = 0; m < 4; ++m) { bf16_t* rowp = base + (size_t)(ai * HALF + m * 16) * ldc;
                float r[8];
#pragma unroll
                for (int n = 0; n < 2; ++n)
#pragma unroll
                    for (int e = 0; e < 4; ++e) { const float g = acc[ai][0][m][n][e], up = acc[ai][1][m][n][e]; r[n * 4 + e] = g * __builtin_amdgcn_rcpf(1.0f + __expf(-g)) * up; }
                u32x4 w; w.x = cvt_pk_bf16(r[0], r[1]); w.y = cvt_pk_bf16(r[2], r[3]); w.z = cvt_pk_bf16(r[4], r[5]); w.w = cvt_pk_bf16(r[6], r[7]);
                *(u32x4*)rowp = w; }
    }
};
struct EpiRes {
    static constexpr bool PERM = false;
    float* X; float sc;
    __device__ __forceinline__ void operator()(const f32x4 (&acc)[2][2][4][2], const Unit& u, int wr, int wc, int fr, int fq) const {
        float* base = X + u.offC + (size_t)(wr * 64 + fr) * 1024 + wc * 32 + 4 * fq;
#pragma unroll
        for (int ai = 0; ai < 2; ++ai)
#pragma unroll
            for (int m = 0; m < 4; ++m) { float* rowp = base + (size_t)(ai * HALF + m * 16) * 1024;
#pragma unroll
                for (int bj = 0; bj < 2; ++bj)
#pragma unroll
                    for (int n = 0; n < 2; ++n) { f32x4* q = (f32x4*)(rowp + bj * HALF + n * 16); *q = *q + acc[ai][bj][m][n] * sc; } }
    }
};

template <class Epi>
__device__ __forceinline__ void gemm_phase(LAS unsigned char* lds, const Gemm g, const Sched& S, const Epi& E) {
    const int tid = opaque_tid(), wid = __builtin_amdgcn_readfirstlane(tid >> 6), lane = tid & 63, wr = wid >> 2, wc = wid & 3, fr = lane & 15, fq = lane >> 4;
    const int K = g.K, nt = K / BK;
    unsigned voffA[2], voffB[2];
#pragma unroll
    for (int i = 0; i < 2; ++i) { int R, C; stage_rc(tid * 16 + i * 8192, R, C); const int Rb = Epi::PERM ? ((R & ~31) + perm32(R & 31)) : R;
        voffA[i] = (unsigned)(R * g.lda + C) * 2u; voffB[i] = (unsigned)(Rb * g.ldb + C) * 2u; }
    const size_t kstep = (size_t)(BK * 2);
    const size_t hstepA = (size_t)HALF * g.lda * 2, hstepB = (size_t)HALF * g.ldb * 2;
    const unsigned ldsw = (unsigned)wid * 1024u;
    const int aoff = lds_byte(wr * 64 + fr, fq * 8), boff = lds_byte(wc * 32 + fr, fq * 8);
#define PG8_SA(b, h) (((b) * 2 + (h)) * HTB)
#define PG8_SB(b, h) ((4 + (b) * 2 + (h)) * HTB)
#define PG8_STAGE(bufoff, gbase, voff) do { _Pragma("unroll") for (int _i = 0; _i < 2; ++_i) \
        __builtin_amdgcn_global_load_lds((const unsigned*)((const char*)(gbase) + (voff)[_i]), (LAS unsigned*)(lds + (bufoff) + ldsw + _i * 8192), 16, 0, 0); } while (0)
#define PG8_LDA(dst, b, h) do { _Pragma("unroll") for (int m = 0; m < 4; ++m) _Pragma("unroll") for (int k = 0; k < 2; ++k) dst[m][k] = *(const LAS bf16x8*)(lds + PG8_SA(b, h) + aoff + m * 2048 + k * 1024); } while (0)
#define PG8_LDB(dst, b, h) do { _Pragma("unroll") for (int n = 0; n < 2; ++n) _Pragma("unroll") for (int k = 0; k < 2; ++k) dst[n][k] = *(const LAS bf16x8*)(lds + PG8_SB(b, h) + boff + n * 2048 + k * 1024); } while (0)
#define PG8_MMA(ai, bj, At, Bt) do { __builtin_amdgcn_s_setprio(1); _Pragma("unroll") for (int m = 0; m < 4; ++m) _Pragma("unroll") for (int n = 0; n < 2; ++n) _Pragma("unroll") for (int k = 0; k < 2; ++k) \
        acc[ai][bj][m][n] = __builtin_amdgcn_mfma_f32_16x16x32_bf16(Bt[n][k], At[m][k], acc[ai][bj][m][n], 0, 0, 0); __builtin_amdgcn_s_setprio(0); } while (0)
#define PG8_WAIT_V(n) asm volatile("s_waitcnt vmcnt(" #n ")" ::: "memory")
#define PG8_WAIT_L(n) asm volatile("s_waitcnt lgkmcnt(" #n ")" ::: "memory")
#define PG8_BAR __builtin_amdgcn_s_barrier()
#define PG8_SCHED __builtin_amdgcn_sched_barrier(0)
    Unit cur, nxt; int ui = 0;
    if (!S.next(0, cur)) return;
    f32x4 acc[2][2][4][2];
#pragma unroll
    for (int a = 0; a < 2; ++a)
#pragma unroll
        for (int b = 0; b < 2; ++b)
#pragma unroll
            for (int m = 0; m < 4; ++m)
#pragma unroll
                for (int n = 0; n < 2; ++n) acc[a][b][m][n] = (f32x4){0.f, 0.f, 0.f, 0.f};
    bf16x8 At[4][2], B0[2][2], B1[2][2];
    const char* cA = g.A + cur.offA; const char* cB = g.Bt + cur.offB;
    PG8_STAGE(PG8_SB(0, 0), cB, voffB); PG8_STAGE(PG8_SB(0, 1), cB + hstepB, voffB); PG8_STAGE(PG8_SA(0, 0), cA, voffA); PG8_STAGE(PG8_SA(0, 1), cA + hstepA, voffA);
    if (wr == 1) PG8_BAR;
    PG8_WAIT_V(2); PG8_BAR;
    PG8_STAGE(PG8_SB(1, 0), cB + kstep, voffB); PG8_STAGE(PG8_SA(1, 0), cA + kstep, voffA); PG8_STAGE(PG8_SB(1, 1), cB + hstepB + kstep, voffB);
    PG8_WAIT_V(6); PG8_BAR;
    for (;;) {
        const bool has_next = S.next(ui + 1, nxt);
        const char* nA = has_next ? g.A + nxt.offA : cA; const char* nB = has_next ? g.Bt + nxt.offB : cB;
        for (int t = 0; t < nt; t += 2) {
            const bool last = (t == nt - 2);
            const char* a1 = cA + (size_t)(t + 1) * kstep;
            const char* a2 = last ? nA : cA + (size_t)(t + 2) * kstep; const char* b2 = last ? nB : cB + (size_t)(t + 2) * kstep;
            const char* a3 = a2 + kstep; const char* b3 = b2 + kstep;
            PG8_LDB(B0, 0, 0); PG8_LDB(B1, 0, 1); PG8_SCHED; PG8_LDA(At, 0, 0); PG8_STAGE(PG8_SA(1, 1), a1 + hstepA, voffA);
            PG8_WAIT_V(8); PG8_WAIT_L(0); PG8_BAR; PG8_MMA(0, 0, At, B0); PG8_MMA(0, 1, At, B1); PG8_BAR; PG8_SCHED;
            PG8_LDA(At, 0, 1); PG8_STAGE(PG8_SB(0, 0), b2, voffB); PG8_STAGE(PG8_SB(0, 1), b2 + hstepB, voffB); PG8_STAGE(PG8_SA(0, 0), a2, voffA);
            PG8_WAIT_V(8); PG8_WAIT_L(0); PG8_BAR; PG8_MMA(1, 0, At, B0); PG8_MMA(1, 1, At, B1); PG8_BAR; PG8_SCHED;
            PG8_LDB(B0, 1, 0); PG8_LDB(B1, 1, 1); PG8_SCHED; PG8_LDA(At, 1, 0); PG8_STAGE(PG8_SA(0, 1), a2 + hstepA, voffA);
            PG8_WAIT_V(8); PG8_WAIT_L(0); PG8_BAR; PG8_MMA(0, 0, At, B0); PG8_MMA(0, 1, At, B1); PG8_BAR; PG8_SCHED;
            PG8_LDA(At, 1, 1); PG8_STAGE(PG8_SB(1, 0), b3, voffB); PG8_STAGE(PG8_SB(1, 1), b3 + hstepB, voffB); PG8_STAGE(PG8_SA(1, 0), a3, voffA);
            PG8_WAIT_V(8); PG8_WAIT_L(0); PG8_BAR; PG8_MMA(1, 0, At, B0); PG8_MMA(1, 1, At, B1); PG8_BAR; PG8_SCHED;
        }
        if (wr == 0) PG8_BAR;
        E(acc, cur, wr, wc, fr, fq);
        if (!has_next) break;
#pragma unroll
        for (int a = 0; a < 2; ++a)
#pragma unroll
            for (int b = 0; b < 2; ++b)
#pragma unroll
                for (int m = 0; m < 4; ++m)
#pragma unroll
                    for (int n = 0; n < 2; ++n) acc[a][b][m][n] = (f32x4){0.f, 0.f, 0.f, 0.f};
        cur = nxt; cA = nA; cB = nB; ++ui;
        if (wr == 1) PG8_BAR;
    }
    PG8_WAIT_V(0);
    PG8_BAR;
#undef PG8_SA
#undef PG8_SB
#undef PG8_STAGE
#undef PG8_LDA
#undef PG8_LDB
#undef PG8_MMA
#undef PG8_WAIT_V
#undef PG8_WAIT_L
#undef PG8_BAR
#undef PG8_SCHED
}
}

__device__ __forceinline__ void transpose_item(const float* W, int K, int N, bf16_t* WT, int out_row0, int k0, int n0, LAS float* scr, int lane) {
    const int n = n0 + (lane & 31);
#pragma unroll 8
    for (int i = 0; i < 32; ++i) { const int kk = 2 * i + (lane >> 5); scr[kk * 33 + (lane & 31)] = (n < N) ? W[(size_t)(k0 + kk) * N + n] : 0.f; }
    asm volatile("s_waitcnt lgkmcnt(0)" ::: "memory");
    const int c = lane & 7;
#pragma unroll
    for (int j = 0; j < 4; ++j) { const int nn = (lane >> 3) + 8 * j; const LAS float* s = scr + (8 * c) * 33 + nn;
        u32x4 o; o.x = pk2(s[0 * 33], s[1 * 33]); o.y = pk2(s[2 * 33], s[3 * 33]); o.z = pk2(s[4 * 33], s[5 * 33]); o.w = pk2(s[6 * 33], s[7 * 33]);
        *(u32x4*)(WT + (size_t)(out_row0 + nn) * K + k0 + 8 * c) = o; }
    asm volatile("s_waitcnt lgkmcnt(0)" ::: "memory");
}

__device__ __forceinline__ void rms_row(const float* xrow, const float* gain, bf16_t* orow, float* copyrow, int lane) {
    const f32x4* xr = (const f32x4*)xrow + lane; const f32x4* gr = (const f32x4*)gain + lane;
    f32x4 v[4]; float s = 0.f;
#pragma unroll
    for (int j = 0; j < 4; ++j) { v[j] = xr[64 * j]; s += (v[j].x * v[j].x + v[j].y * v[j].y) + (v[j].z * v[j].z + v[j].w * v[j].w); }
    if (copyrow) {
#pragma unroll
        for (int j = 0; j < 4; ++j) ((f32x4*)copyrow + lane)[64 * j] = v[j];
    }
    const float rstd = rsqrtf(wave_sum(s) * (1.f / 1024.f) + EPS);
    unsigned long long* o8 = (unsigned long long*)orow + lane;
#pragma unroll
    for (int j = 0; j < 4; ++j) { const f32x4 gg = gr[64 * j]; const f32x4 y = v[j] * rstd * gg;
        o8[64 * j] = (unsigned long long)pk2(y.x, y.y) | ((unsigned long long)pk2(y.z, y.w) << 32); }
}

__device__ __forceinline__ void phase_prep(const Ctx p, LAS unsigned char* lds) {
    const int tid = opaque_tid(), lane = tid & 63, wave = tid >> 6;
    const int gw = blockIdx.x * 8 + wave, NGW = gridDim.x * 8;
    LAS float* scr = (LAS float*)(lds + wave * 16384);
    constexpr int I_GU = 16 * 176, I_D = 44 * 32, I_IN = 16 * 112, I_OUT = 16 * 32, I_KV = 16 * 64, I_O = 16 * 32;
    constexpr int PER_LAYER = 2 * I_GU + 2 * I_D + I_IN + I_OUT + I_KV + I_O;
    for (int it = gw; it < NL * PER_LAYER; it += NGW) {
        const int l = it / PER_LAYER; int r = it % PER_LAYER;
        unsigned char* wl = p.ws() + WS_W + (size_t)l * LAYER_W;
        const float* W; int K, N, NP; bf16_t* WT; int gu = 0;
        if (r < I_GU) { W = p.in(3) + (size_t)l * 1024 * 5632; K = 1024; N = 5632; NP = 5632; WT = (bf16_t*)(wl + W_GU1); gu = 1; }
        else if ((r -= I_GU) < I_GU) { W = p.in(24) + (size_t)l * 1024 * 5632; K = 1024; N = 5632; NP = 5632; WT = (bf16_t*)(wl + W_GU2); gu = 1; }
        else if ((r -= I_GU) < I_D) { W = p.in(4) + (size_t)l * 2816 * 1024; K = 2816; N = 1024; NP = 1024; WT = (bf16_t*)(wl + W_D1); }
        else if ((r -= I_D) < I_D) { W = p.in(25) + (size_t)l * 2816 * 1024; K = 2816; N = 1024; NP = 1024; WT = (bf16_t*)(wl + W_D2); }
        else if ((r -= I_D) < I_IN) { W = p.in(6) + (size_t)l * 1024 * DIN; K = 1024; N = DIN; NP = DINP; WT = (bf16_t*)(wl + W_IN); }
        else if ((r -= I_IN) < I_OUT) { W = p.in(7) + (size_t)l * 1024 * 1024; K = 1024; N = 1024; NP = 1024; WT = (bf16_t*)(wl + W_OUT); }
        else if ((r -= I_OUT) < I_KV) { W = p.in(21) + (size_t)l * 1024 * 2048; K = 1024; N = 2048; NP = 2048; WT = (bf16_t*)(wl + W_KV); }
        else { r -= I_KV; W = p.in(22) + (size_t)l * 1024 * 1024; K = 1024; N = 1024; NP = 1024; WT = (bf16_t*)(wl + W_O); }
        const int nblk = NP / 32, kb = r / nblk, nb = r % nblk, n0 = nb * 32;
        int orow = n0;
        if (gu) { const int f = (n0 < 2816) ? n0 : n0 - 2816; orow = (f >> 7) * 256 + (f & 127) + ((n0 < 2816) ? 0 : 128); }
        transpose_item(W, K, N, WT, orow, kb * 64, n0, scr, lane);
    }
    const int gt = blockIdx.x * 512 + tid, NGT = gridDim.x * 512;
    for (int i = gt; i < NL * 1024 * 1024 / 4; i += NGT) {
        const int l = i / (1024 * 1024 / 4), e = i % (1024 * 1024 / 4);
        const f32x4 v = ((const f32x4*)(p.in(20) + (size_t)l * 1024 * 1024))[e];
        u32x2 o; o.x = pk2(v.x, v.y); o.y = pk2(v.z, v.w);
        ((u32x2*)(p.ws() + WS_W + (size_t)l * LAYER_W + W_Q))[e] = o;
    }
    float* rc = (float*)(p.ws() + WS_ROPE); float* rs = rc + 4096 * 32;
    for (int i = gt; i < 4096 * 32; i += NGT) {
        const int s = i >> 5, d = i & 31;
        const float ang = (float)s * p.invf(d);
        const float n = rintf(ang * 0.15915494309189535f);
        float r = fmaf(-n, 6.2831854820251465f, ang); r = fmaf(-n, -1.7484555e-07f, r);
        rc[i] = cosf(r); rs[i] = sinf(r);
    }
    for (int m = gw; m < NL * 4096; m += NGW) { const int l = m >> 12, rr = m & 4095;
        rms_row(p.in(1) + (size_t)rr * 1024, p.in(19) + l * 1024, (bf16_t*)(p.ws() + WS_MEMN) + (size_t)m * 1024, nullptr, lane); }
}

__device__ __forceinline__ void phase_norm(const Ctx p, const float* src, const float* gain, float* copy) {
    const int tid_ = opaque_tid(), lane = tid_ & 63, wave = tid_ >> 6;
    const int gw = blockIdx.x * 8 + wave, NGW = gridDim.x * 8;
    bf16_t* hn = (bf16_t*)(p.ws() + WS_HN);
    for (int m = gw; m < TT; m += NGW) rms_row(src + (size_t)m * 1024, gain, hn + (size_t)m * 1024, copy ? copy + (size_t)m * 1024 : nullptr, lane);
}

__device__ __forceinline__ void phase_final(const Ctx p) {
    const int tid_ = opaque_tid(), lane = tid_ & 63, wave = tid_ >> 6;
    const int gw = blockIdx.x * 8 + wave, NGW = gridDim.x * 8;
    const f32x4* gr = (const f32x4*)p.in(26) + lane;
    for (int m = gw; m < TT; m += NGW) {
        f32x4* xr = (f32x4*)(p.out() + (size_t)m * 1024) + lane;
        f32x4 v[4]; float s = 0.f;
#pragma unroll
        for (int j = 0; j < 4; ++j) { v[j] = xr[64 * j]; s += (v[j].x * v[j].x + v[j].y * v[j].y) + (v[j].z * v[j].z + v[j].w * v[j].w); }
        const float rstd = rsqrtf(wave_sum(s) * (1.f / 1024.f) + EPS);
#pragma unroll
        for (int j = 0; j < 4; ++j) xr[64 * j] = v[j] * rstd * gr[64 * j];
    }
}

__device__ __forceinline__ void phase_softmax(const Ctx p) {
    const int tid_ = opaque_tid(), lane = tid_ & 63, wave = tid_ >> 6;
    const int gw = blockIdx.x * 8 + wave, NGW = gridDim.x * 8;
    bf16_t* S = (bf16_t*)(p.ws() + WS_PROJ);
    for (int m = gw; m < TT; m += NGW) {
        u32x4* rp = (u32x4*)(S + (size_t)m * 1024) + lane * 2;
        const u32x4 w0 = rp[0], w1 = rp[1];
        float v[16];
        v[0] = bflo(w0.x); v[1] = bfhi(w0.x); v[2] = bflo(w0.y); v[3] = bfhi(w0.y); v[4] = bflo(w0.z); v[5] = bfhi(w0.z); v[6] = bflo(w0.w); v[7] = bfhi(w0.w);
        v[8] = bflo(w1.x); v[9] = bfhi(w1.x); v[10] = bflo(w1.y); v[11] = bfhi(w1.y); v[12] = bflo(w1.z); v[13] = bfhi(w1.z); v[14] = bflo(w1.w); v[15] = bfhi(w1.w);
        float mx = v[0];
#pragma unroll
        for (int i = 1; i < 16; ++i) mx = fmaxf(mx, v[i]);
#pragma unroll
        for (int o = 1; o < 16; o <<= 1) mx = fmaxf(mx, __shfl_xor(mx, o));
        float sum = 0.f;
#pragma unroll
        for (int i = 0; i < 16; ++i) { v[i] = __expf(v[i] - mx); sum += v[i]; }
#pragma unroll
        for (int o = 1; o < 16; o <<= 1) sum += __shfl_xor(sum, o);
        const float inv = 1.0f / sum;
        u32x4 o0, o1;
        o0.x = pk2(v[0] * inv, v[1] * inv); o0.y = pk2(v[2] * inv, v[3] * inv); o0.z = pk2(v[4] * inv, v[5] * inv); o0.w = pk2(v[6] * inv, v[7] * inv);
        o1.x = pk2(v[8] * inv, v[9] * inv); o1.y = pk2(v[10] * inv, v[11] * inv); o1.z = pk2(v[12] * inv, v[13] * inv); o1.w = pk2(v[14] * inv, v[15] * inv);
        rp[0] = o0; rp[1] = o1;
    }
}

constexpr int PQ = 68;
constexpr int PB = 72;
constexpr int ARRB = 64 * PB * 2;
constexpr int M_QP = 0, M_QN = M_QP + ARRB, M_KN = M_QN + ARRB, M_KP = M_KN + ARRB, M_KNT = M_KP + ARRB, M_VT = M_KNT + ARRB, M_SC = M_VT + ARRB, M_STT = M_SC + ARRB,
              M_G = M_STT + ARRB, M_SEG = M_G + 64 * PQ * 4, M_CL = M_SEG + 8 * 64 * 4, M_RF = M_CL + 256, M_W2 = M_RF + 256, M_BA = M_W2 + 2048, M_END = M_BA + 128;
static_assert(M_END <= PARAM_OFF, "mixer LDS");
#define LBAR() do { asm volatile("s_waitcnt lgkmcnt(0)" ::: "memory"); __builtin_amdgcn_s_barrier(); asm volatile("" ::: "memory"); } while (0)

__device__ __forceinline__ void unpack8(const u32x4 w, float (&f)[8]) {
    f[0] = bflo(w.x); f[1] = bfhi(w.x); f[2] = bflo(w.y); f[3] = bfhi(w.y); f[4] = bflo(w.z); f[5] = bfhi(w.z); f[6] = bflo(w.w); f[7] = bfhi(w.w);
}
__device__ __forceinline__ bf16x8 ldfrag(LAS unsigned char* arr, int r0, int k0, int lane) {
    return *(const LAS bf16x8*)(arr + (((r0 + (lane & 15)) * PB + k0 + ((lane >> 4) << 3)) << 1));
}
__device__ __forceinline__ void st4bf(LAS unsigned char* arr, int r, int c, float a, float b, float c2, float d) {
    u32x2 w; w.x = pk2(a, b); w.y = pk2(c2, d); *(LAS u32x2*)(arr + ((r * PB + c) << 1)) = w;
}
__device__ __forceinline__ void st1bf(LAS unsigned char* arr, int r, int c, float a) { *(LAS unsigned short*)(arr + ((r * PB + c) << 1)) = (unsigned short)f2bf(a); }
#define MFMA16(a, b, c) __builtin_amdgcn_mfma_f32_16x16x32_bf16((a), (b), (c), 0, 0, 0)

template <int MIX>
__device__ __forceinline__ void mix_load(const bf16_t* pr, const float* rope, int h, int cgp, u32x4& r0, u32x4& r1, u32x4& r2, u32x4& r3, u32x4& rv) {
    if constexpr (MIX == 0) {
        rv = *(const u32x4*)(pr + 512 + h * 64 + cgp * 8);
        const u32x2 a = *(const u32x2*)(pr + h * 64 + 4 * cgp), b = *(const u32x2*)(pr + h * 64 + 32 + 4 * cgp);
        const u32x2 c = *(const u32x2*)(pr + 256 + h * 64 + 4 * cgp), d = *(const u32x2*)(pr + 256 + h * 64 + 32 + 4 * cgp);
        r0 = (u32x4){a.x, a.y, b.x, b.y}; r1 = (u32x4){c.x, c.y, d.x, d.y};
        r2 = *(const u32x4*)(rope + 4 * cgp); r3 = *(const u32x4*)(rope + 4096 * 32 + 4 * cgp);
    } else if constexpr (MIX == 2) {
        rv = *(const u32x4*)(pr + 1792 + h * 64 + cgp * 8);
        const u32x2 a = *(const u32x2*)(pr + 1536 + h * 32 + 4 * cgp), b = *(const u32x2*)(pr + 1664 + h * 32 + 4 * cgp);
        r0 = (u32x4){a.x, a.y, b.x, b.y}; r1 = *(const u32x4*)(pr + 2048); r2 = *(const u32x4*)(pr + 2056); r3 = r2;
    } else {
        rv = *(const u32x4*)(pr + 2832 + h * 64 + cgp * 8);
        r0 = *(const u32x4*)(pr + 2320 + h * 64 + 8 * cgp); r1 = *(const u32x4*)(pr + 2576 + h * 64 + 8 * cgp); r2 = r1; r3 = r1;
    }
}

template <int MIX>
__device__ __forceinline__ void gla_chain(const Ctx p, int l, int b, int h, LAS unsigned char* lds) {
    constexpr int DK = (MIX == 2) ? 32 : 64;
    constexpr bool CAUSAL = (MIX == 3);
    constexpr int NE = DK / 8, NG = NE / 4, KS = DK / 32;
    constexpr int GOFF = MIX == 0 ? 768 : (MIX == 2 ? 2064 : 3088);
    constexpr int YOFF = MIX == 0 ? 0 : (MIX == 2 ? 512 : 768);
    const int tid = opaque_tid(), lane = tid & 63, w = __builtin_amdgcn_readfirstlane(tid >> 6), row = tid >> 3, cgp = tid & 7, quad = lane >> 4, l15 = lane & 15;
    LAS unsigned char* QP = lds + M_QP; LAS unsigned char* QN = lds + M_QN; LAS unsigned char* KN = lds + M_KN; LAS unsigned char* KP = lds + M_KP;
    LAS unsigned char* KNT = lds + M_KNT; LAS unsigned char* VT = lds + M_VT; LAS unsigned char* SC = lds + M_SC; LAS unsigned char* STT = lds + M_STT;
    LAS float* G = (LAS float*)(lds + M_G); LAS float* SEG = (LAS float*)(lds + M_SEG); LAS float* CL = (LAS float*)(lds + M_CL); LAS float* RF = (LAS float*)(lds + M_RF);
    LAS float* W2 = (LAS float*)(lds + M_W2); LAS float* BA = (LAS float*)(lds + M_BA);
    const bf16_t* proj = (const bf16_t*)(p.ws() + WS_PROJ) + (size_t)b * SEQ * DINP;
    bf16_t* Y = (bf16_t*)(p.ws() + WS_HN) + (size_t)b * SEQ * 1024;
    const float* rope = (const float*)(p.ws() + WS_ROPE);
    const int gb0 = (MIX == 3) ? 8 * cgp : 4 * cgp, gb1 = (MIX == 0) ? 32 + 4 * cgp : 8 * cgp + 4;
    f32x4 S[4];
#pragma unroll
    for (int i = 0; i < 4; ++i) S[i] = (f32x4){0.f, 0.f, 0.f, 0.f};
    float lbv[8];
#pragma unroll
    for (int i = 0; i < 8; ++i) lbv[i] = 0.f;
    float lg = 0.f;
    if constexpr (MIX == 0) lg = log1pf(-exp2f(-5.0f - (float)h));
    LBAR();
    if constexpr (MIX == 2) {
        const float* w2 = p.in(15) + (size_t)l * 16 * 128; const float* ba = p.in(16) + (size_t)l * 128;
        { const int r = tid >> 5, d = tid & 31; W2[r * 32 + d] = w2[r * 128 + h * 32 + d]; }
        if (tid < 32) BA[tid] = ba[h * 32 + tid];
    }
    if constexpr (MIX == 3) {
        const float* lg4 = p.in(17);
#pragma unroll
        for (int i = 0; i < 8; ++i) { const int ch = h * 64 + cgp * 8 + i;
            const float a0 = lg4[ch], a1 = lg4[256 + ch], a2 = lg4[512 + ch], a3 = lg4[768 + ch];
            const float mx = fmaxf(fmaxf(a0, a1), fmaxf(a2, a3));
            const float e0 = expf(a0 - mx), e1 = expf(a1 - mx), e2 = expf(a2 - mx), e3 = expf(a3 - mx);
            const float inv = 1.0f / (e0 + e1 + e2 + e3);
            float lb = 0.f; if (l >= 1) lb += e1 * inv; if (l >= 2) lb += e2 * inv; if (l >= 3) lb += e3 * inv;
            lbv[i] = lb; }
    }
    u32x4 r0, r1, r2, r3, rv;
    mix_load<MIX>(proj + (size_t)row * DINP, rope + (size_t)row * 32, h, cgp, r0, r1, r2, r3, rv);
    for (int c = 0; c < 64; ++c) {
        LBAR();
        const int t0 = c * 64;
        u32x2 gt[4];
        if (w < 4) {
#pragma unroll
            for (int et = 0; et < 4; ++et) gt[et] = *(const u32x2*)(proj + (size_t)(t0 + 16 * w + l15) * DINP + GOFF + h * 64 + 16 * et + 4 * quad);
        }
        float q[NE], k[NE], g[NE];
        { float vv[8]; unpack8(rv, vv);
#pragma unroll
          for (int i = 0; i < 8; ++i) st1bf(VT, cgp * 8 + i, row, vv[i]); }
        if constexpr (MIX == 0) {
            const float q1[4] = {bflo(r0.x), bfhi(r0.x), bflo(r0.y), bfhi(r0.y)}, q2[4] = {bflo(r0.z), bfhi(r0.z), bflo(r0.w), bfhi(r0.w)};
            const float k1[4] = {bflo(r1.x), bfhi(r1.x), bflo(r1.y), bfhi(r1.y)}, k2[4] = {bflo(r1.z), bfhi(r1.z), bflo(r1.w), bfhi(r1.w)};
            const float cs[4] = {__uint_as_float(r2.x), __uint_as_float(r2.y), __uint_as_float(r2.z), __uint_as_float(r2.w)};
            const float sn[4] = {__uint_as_float(r3.x), __uint_as_float(r3.y), __uint_as_float(r3.z), __uint_as_float(r3.w)};
#pragma unroll
            for (int i = 0; i < 4; ++i) { q[i] = q1[i] * cs[i] - q2[i] * sn[i]; q[4 + i] = q1[i] * sn[i] + q2[i] * cs[i];
                k[i] = (k1[i] * cs[i] - k2[i] * sn[i]) * 0.125f; k[4 + i] = (k1[i] * sn[i] + k2[i] * cs[i]) * 0.125f; g[i] = lg; g[4 + i] = lg; }
        } else if constexpr (MIX == 2) {
            const float qq[4] = {bflo(r0.x), bfhi(r0.x), bflo(r0.y), bfhi(r0.y)}, kk[4] = {bflo(r0.z), bfhi(r0.z), bflo(r0.w), bfhi(r0.w)};
            float al[16];
            { float t8[8]; unpack8(r1, t8);
#pragma unroll
              for (int i = 0; i < 8; ++i) al[i] = t8[i];
              unpack8(r2, t8);
#pragma unroll
              for (int i = 0; i < 8; ++i) al[8 + i] = t8[i]; }
#pragma unroll
            for (int i = 0; i < 4; ++i) {
                float a = BA[gb0 + i];
#pragma unroll
                for (int r = 0; r < 16; ++r) a += al[r] * W2[r * 32 + gb0 + i];
                const float ls = -(fmaxf(-a, 0.f) + logf(1.0f + __expf(-fabsf(a))));
                q[i] = qq[i] * 0.17677669529663687f; k[i] = kk[i]; g[i] = ls * 0.0625f; }
        } else {
            float qq[8], ff[8]; unpack8(r0, qq); unpack8(r1, ff);
#pragma unroll
            for (int i = 0; i < 8; ++i) {
                const float sg = 1.0f / (1.0f + __expf(-ff[i])), nsg = 1.0f / (1.0f + __expf(ff[i]));
                q[i] = siluf_(qq[i]); k[i] = (1.0f - lbv[i]) * nsg; g[i] = logf(lbv[i] + (1.0f - lbv[i]) * sg); }
        }
#pragma unroll
        for (int gq = 0; gq < NG; ++gq) { const int db = gq ? gb1 : gb0; *(LAS f32x4*)(G + row * PQ + db) = (f32x4){g[4 * gq], g[4 * gq + 1], g[4 * gq + 2], g[4 * gq + 3]}; }
        if (c < 63) mix_load<MIX>(proj + (size_t)(t0 + 64 + row) * DINP, rope + (size_t)(t0 + 64 + row) * 32, h, cgp, r0, r1, r2, r3, rv);
        LBAR();
        const int seg = tid / DK, sd = tid % DK;
        if (tid < 8 * DK) { float cum = 0.f;
#pragma unroll
            for (int r = 0; r < 8; ++r) { cum += G[(8 * seg + r) * PQ + sd]; G[(8 * seg + r) * PQ + sd] = cum; }
            SEG[seg * 64 + sd] = cum; }
        LBAR();
        if (tid < 8 * DK) { float off = 0.f;
#pragma unroll
            for (int s = 0; s < 7; ++s) off += (s < seg) ? SEG[s * 64 + sd] : 0.f;
            float last = 0.f;
#pragma unroll
            for (int r = 0; r < 8; ++r) { last = G[(8 * seg + r) * PQ + sd] + off; G[(8 * seg + r) * PQ + sd] = last; }
            if (seg == 3) RF[sd] = last;
            if (seg == 7) CL[sd] = last; }
        LBAR();
#pragma unroll
        for (int gq = 0; gq < NG; ++gq) { const int db = gq ? gb1 : gb0;
            const f32x4 cv = *(const LAS f32x4*)(G + row * PQ + db), rf = *(const LAS f32x4*)(RF + db);
            float e1[4], e2[4];
#pragma unroll
            for (int i = 0; i < 4; ++i) { e1[i] = __expf(cv[i] - rf[i]); e2[i] = __expf(rf[i] - cv[i]); }
            st4bf(QP, row, db, q[4 * gq] * e1[0], q[4 * gq + 1] * e1[1], q[4 * gq + 2] * e1[2], q[4 * gq + 3] * e1[3]);
            st4bf(KN, row, db, k[4 * gq] * e2[0], k[4 * gq + 1] * e2[1], k[4 * gq + 2] * e2[2], k[4 * gq + 3] * e2[3]);
#pragma unroll
            for (int i = 0; i < 4; ++i) st1bf(KNT, db + i, row, k[4 * gq + i] * e2[i]);
            if constexpr (!CAUSAL) {
                st4bf(QN, row, db, q[4 * gq] * e2[0], q[4 * gq + 1] * e2[1], q[4 * gq + 2] * e2[2], q[4 * gq + 3] * e2[3]);
                st4bf(KP, row, db, k[4 * gq] * e1[0], k[4 * gq + 1] * e1[1], k[4 * gq + 2] * e1[2], k[4 * gq + 3] * e1[3]); } }
        if (w >= 4 && (w - 4) < DK / 16) { const int dd = 16 * (w - 4) + 4 * quad; const f32x4 rf = *(const LAS f32x4*)(RF + dd);
            const float x0 = __expf(rf[0]), x1 = __expf(rf[1]), x2 = __expf(rf[2]), x3 = __expf(rf[3]);
#pragma unroll
            for (int et = 0; et < 4; ++et) st4bf(STT, 16 * et + l15, dd, x0 * S[et][0], x1 * S[et][1], x2 * S[et][2], x3 * S[et][3]); }
        LBAR();
        {
            const int j0 = 16 * (w >> 1);
            bf16x8 bqp[KS], bqn[KS];
#pragma unroll
            for (int ks = 0; ks < KS; ++ks) { bqp[ks] = ldfrag(QP, j0, 32 * ks, lane); if constexpr (!CAUSAL) bqn[ks] = ldfrag(QN, j0, 32 * ks, lane); else bqn[ks] = bqp[ks]; }
#pragma unroll
            for (int tc = 0; tc < 2; ++tc) { const int m0 = 16 * (2 * (w & 1) + tc);
                f32x4 lo = (f32x4){0.f, 0.f, 0.f, 0.f}, up = lo;
#pragma unroll
                for (int ks = 0; ks < KS; ++ks) { lo = MFMA16(ldfrag(KN, m0, 32 * ks, lane), bqp[ks], lo);
                    if constexpr (!CAUSAL) up = MFMA16(ldfrag(KP, m0, 32 * ks, lane), bqn[ks], up); }
                const int j = j0 + l15, m = m0 + 4 * quad;
                float v[4];
#pragma unroll
                for (int i = 0; i < 4; ++i) v[i] = (m + i <= j) ? lo[i] : (CAUSAL ? 0.f : up[i]);
                st4bf(SC, j, m, v[0], v[1], v[2], v[3]); }
        }
        LBAR();
        if (w < 4) {
            const int j0 = 16 * w;
            bf16x8 bsc[2], bq[KS];
            bsc[0] = ldfrag(SC, j0, 0, lane); bsc[1] = ldfrag(SC, j0, 32, lane);
#pragma unroll
            for (int ks = 0; ks < KS; ++ks) bq[ks] = ldfrag(QP, j0, 32 * ks, lane);
            f32x4 o[4];
#pragma unroll
            for (int et = 0; et < 4; ++et) { f32x4 a = (f32x4){0.f, 0.f, 0.f, 0.f};
                a = MFMA16(ldfrag(VT, 16 * et, 0, lane), bsc[0], a); a = MFMA16(ldfrag(VT, 16 * et, 32, lane), bsc[1], a);
#pragma unroll
                for (int ks = 0; ks < KS; ++ks) a = MFMA16(ldfrag(STT, 16 * et, 32 * ks, lane), bq[ks], a);
                o[et] = a; }
            float s = 0.f;
#pragma unroll
            for (int et = 0; et < 4; ++et) s += (o[et][0] + o[et][1]) + (o[et][2] + o[et][3]);
            s += __shfl_xor(s, 16); s += __shfl_xor(s, 32);
            const float mu = s * (1.0f / 64.0f);
            float qv = 0.f;
#pragma unroll
            for (int et = 0; et < 4; ++et) { o[et] = o[et] - mu; qv += (o[et][0] * o[et][0] + o[et][1] * o[et][1]) + (o[et][2] * o[et][2] + o[et][3] * o[et][3]); }
            qv += __shfl_xor(qv, 16); qv += __shfl_xor(qv, 32);
            const float rstd = rsqrtf(qv * (1.0f / 64.0f) + EPS);
            bf16_t* yr = Y + (size_t)(t0 + j0 + l15) * 1024 + YOFF + h * 64 + 4 * quad;
#pragma unroll
            for (int et = 0; et < 4; ++et) { const float g0 = bflo(gt[et].x), g1 = bfhi(gt[et].x), g2 = bflo(gt[et].y), g3 = bfhi(gt[et].y);
                u32x2 wv; wv.x = pk2(siluf_(g0) * o[et][0] * rstd, siluf_(g1) * o[et][1] * rstd); wv.y = pk2(siluf_(g2) * o[et][2] * rstd, siluf_(g3) * o[et][3] * rstd);
                *(u32x2*)(yr + 16 * et) = wv; }
        } else if ((w - 4) < DK / 16) {
            const int d0 = 16 * (w - 4);
            const bf16x8 a0 = ldfrag(KNT, d0, 0, lane), a1 = ldfrag(KNT, d0, 32, lane);
            const f32x4 cl = *(const LAS f32x4*)(CL + d0 + 4 * quad), rf = *(const LAS f32x4*)(RF + d0 + 4 * quad);
            f32x4 ec, ef;
#pragma unroll
            for (int i = 0; i < 4; ++i) { ec[i] = __expf(cl[i]); ef[i] = __expf(cl[i] - rf[i]); }
#pragma unroll
            for (int et = 0; et < 4; ++et) { f32x4 a = (f32x4){0.f, 0.f, 0.f, 0.f};
                a = MFMA16(a0, ldfrag(VT, 16 * et, 0, lane), a); a = MFMA16(a1, ldfrag(VT, 16 * et, 32, lane), a);
                S[et] = ec * S[et] + ef * a; }
        }
    }
    LBAR();
}

constexpr int R_XB = 0, R_XCF = 17408, R_XCB = R_XCF + 64 * PQ * 4, R_WAT = R_XCB + ARRB, R_WXT = R_WAT + ARRB, R_AA = R_WXT + ARRB, R_UU = R_AA + 16384, R_CW = R_UU + 16384,
              R_CB = R_CW + 1024, R_BA = R_CB + 256, R_BX = R_BA + 256, R_LS = R_BX + 256, R_END = R_LS + 256;
static_assert(R_END <= PARAM_OFF, "lru LDS");

__device__ __forceinline__ void lru_chain(const Ctx p, int l, int b, int n, LAS unsigned char* lds) {
    const int tid = opaque_tid(), lane = tid & 63, w = __builtin_amdgcn_readfirstlane(tid >> 6), row = tid >> 3, cgp = tid & 7, quad = lane >> 4, l15 = lane & 15;
    LAS float* XB = (LAS float*)(lds + R_XB); LAS float* XCF = (LAS float*)(lds + R_XCF); LAS unsigned char* XCB = lds + R_XCB; LAS unsigned char* WAT = lds + R_WAT; LAS unsigned char* WXT = lds + R_WXT;
    LAS float* AA = (LAS float*)(lds + R_AA); LAS float* UU = (LAS float*)(lds + R_UU); LAS float* CW = (LAS float*)(lds + R_CW); LAS float* CB = (LAS float*)(lds + R_CB);
    LAS float* BAv = (LAS float*)(lds + R_BA); LAS float* BXv = (LAS float*)(lds + R_BX); LAS float* LS = (LAS float*)(lds + R_LS);
    const bf16_t* proj = (const bf16_t*)(p.ws() + WS_PROJ) + (size_t)b * SEQ * DINP;
    bf16_t* Y = (bf16_t*)(p.ws() + WS_HN) + (size_t)b * SEQ * 1024;
    LBAR();
    { const float* wa = p.in(10) + ((size_t)l * 4 + n) * 4096; const float* wx = p.in(12) + ((size_t)l * 4 + n) * 4096;
#pragma unroll
      for (int i = 0; i < 8; ++i) { const int idx = tid + 512 * i, d = idx >> 6, e = idx & 63; st1bf(WAT, e, d, wa[idx]); st1bf(WXT, e, d, wx[idx]); }
      if (tid < 256) CW[tid] = p.in(8)[(size_t)l * 1024 + (tid >> 6) * 256 + n * 64 + (tid & 63)];
      if (tid < 64) { const int ch = n * 64 + tid; CB[tid] = p.in(9)[(size_t)l * 256 + ch]; BAv[tid] = p.in(11)[(size_t)l * 256 + ch]; BXv[tid] = p.in(13)[(size_t)l * 256 + ch];
          const float lam = p.in(14)[(size_t)l * 256 + ch]; LS[tid] = -8.0f * (fmaxf(-lam, 0.f) + log1pf(expf(-fabsf(lam)))); }
      if (tid < 192) XB[tid] = 0.f; }
    float hreg = 0.f;
    u32x4 xr = *(const u32x4*)(proj + (size_t)row * DINP + 1024 + n * 64 + cgp * 8);
    for (int c = 0; c < 64; ++c) {
        LBAR();
        const int t0 = c * 64;
        const u32x4 gr = *(const u32x4*)(proj + (size_t)(t0 + row) * DINP + 1280 + n * 64 + cgp * 8);
        float xv[8]; unpack8(xr, xv);
#pragma unroll
        for (int i = 0; i < 8; ++i) XB[(row + 3) * 64 + cgp * 8 + i] = xv[i];
        if (c < 63) xr = *(const u32x4*)(proj + (size_t)(t0 + 64 + row) * DINP + 1024 + n * 64 + cgp * 8);
        LBAR();
        { float xc[8];
#pragma unroll
          for (int i = 0; i < 8; ++i) { const int ch = cgp * 8 + i;
              xc[i] = CB[ch] + CW[ch] * XB[row * 64 + ch] + CW[64 + ch] * XB[(row + 1) * 64 + ch] + CW[128 + ch] * XB[(row + 2) * 64 + ch] + CW[192 + ch] * XB[(row + 3) * 64 + ch]; }
          *(LAS f32x4*)(XCF + row * PQ + cgp * 8) = (f32x4){xc[0], xc[1], xc[2], xc[3]}; *(LAS f32x4*)(XCF + row * PQ + cgp * 8 + 4) = (f32x4){xc[4], xc[5], xc[6], xc[7]};
          u32x4 wv; wv.x = pk2(xc[0], xc[1]); wv.y = pk2(xc[2], xc[3]); wv.z = pk2(xc[4], xc[5]); wv.w = pk2(xc[6], xc[7]);
          *(LAS u32x4*)(XCB + ((row * PB + cgp * 8) << 1)) = wv; }
        LBAR();
        if (row >= 61) {
#pragma unroll
            for (int i = 0; i < 8; ++i) XB[(row - 61) * 64 + cgp * 8 + i] = xv[i]; }
        {
            const int tt = 16 * (w >> 1);
            const bf16x8 b0 = ldfrag(XCB, tt, 0, lane), b1 = ldfrag(XCB, tt, 32, lane);
#pragma unroll
            for (int tc = 0; tc < 2; ++tc) { const int e0 = 16 * (2 * (w & 1) + tc);
                f32x4 ar = (f32x4){0.f, 0.f, 0.f, 0.f}, ai = ar;
                ar = MFMA16(ldfrag(WAT, e0, 0, lane), b0, ar); ar = MFMA16(ldfrag(WAT, e0, 32, lane), b1, ar);
                ai = MFMA16(ldfrag(WXT, e0, 0, lane), b0, ai); ai = MFMA16(ldfrag(WXT, e0, 32, lane), b1, ai);
                const int t = tt + l15, e4 = e0 + 4 * quad;
                const f32x4 ba = *(const LAS f32x4*)(BAv + e4), bx = *(const LAS f32x4*)(BXv + e4), ls = *(const LAS f32x4*)(LS + e4), xc = *(const LAS f32x4*)(XCF + t * PQ + e4);
                f32x4 av, uv;
#pragma unroll
                for (int i = 0; i < 4; ++i) { const float r = sigmoidf_(ar[i] + ba[i]), ig = sigmoidf_(ai[i] + bx[i]);
                    const float la = r * ls[i]; av[i] = __expf(la); uv[i] = sqrtf(-expm1f(2.0f * la)) * (ig * xc[i]); }
                *(LAS f32x4*)(AA + t * 64 + e4) = av; *(LAS f32x4*)(UU + t * 64 + e4) = uv; }
        }
        LBAR();
        if (tid < 64) {
#pragma unroll 16
            for (int t = 0; t < 64; ++t) { hreg = AA[t * 64 + tid] * hreg + UU[t * 64 + tid]; UU[t * 64 + tid] = hreg; } }
        LBAR();
        { float gv[8]; unpack8(gr, gv);
          float o[8];
#pragma unroll
          for (int i = 0; i < 8; ++i) { const float x = gv[i], z = 0.7978845608028654f * (x + 0.044715f * x * x * x);
              const float th = 1.0f - 2.0f / (1.0f + __expf(2.0f * z)); o[i] = UU[row * 64 + cgp * 8 + i] * 0.5f * x * (1.0f + th); }
          u32x4 wv; wv.x = pk2(o[0], o[1]); wv.y = pk2(o[2], o[3]); wv.z = pk2(o[4], o[5]); wv.w = pk2(o[6], o[7]);
          *(u32x4*)(Y + (size_t)(t0 + row) * 1024 + 256 + n * 64 + cgp * 8) = wv; }
    }
    LBAR();
}

__device__ __forceinline__ void phase_mix(const Ctx p, int l, LAS unsigned char* lds) {
    LAS unsigned char* sm = lds;
    for (int cid = blockIdx.x; cid < 256; cid += gridDim.x) {
        const int mixer = cid & 3, w = cid >> 2, b = w >> 2, h = w & 3;
        if (mixer == 0) gla_chain<0>(p, l, b, h, sm);
        else if (mixer == 1) lru_chain(p, l, b, h, sm);
        else if (mixer == 2) gla_chain<2>(p, l, b, h, sm);
        else gla_chain<3>(p, l, b, h, sm);
    }
}


#define XB_TMO      128
#define XB_XCNT(j)  (256  + 64 * (j))
#define XB_XSUB(j)  (1280 + 64 * (j))
#define XB_XGEN(j)  (2304 + 64 * (j))
#define XB_TOP      3328
#define XB_TOPGEN   3392
#define XCD_BAR_WORDS 3456
#define XB_SPIN_CAP (1u << 22)
__device__ __forceinline__ unsigned xb_ld(unsigned* p)              { return __hip_atomic_load(p, __ATOMIC_RELAXED, __HIP_MEMORY_SCOPE_AGENT); }
__device__ __forceinline__ unsigned xb_add(unsigned* p, unsigned v) { return __hip_atomic_fetch_add(p, v, __ATOMIC_RELAXED, __HIP_MEMORY_SCOPE_AGENT); }
__device__ __forceinline__ unsigned xb_xcc_id() { return (unsigned)__builtin_amdgcn_s_getreg((3 << 11) | 20) & 0xFu; }
#define XB_SPIN(cond, bar) do { unsigned _sp = 0; while (cond) { __builtin_amdgcn_s_sleep(1); \
    if ((++_sp & 255u) == 0u) { if (xb_ld(&(bar)[XB_TMO])) break; if (_sp > XB_SPIN_CAP) { atomicAdd(&(bar)[XB_TMO], 1u); break; } } } } while (0)
struct XcdBarrier { unsigned* bar; unsigned x; volatile LAS unsigned* st; };
__device__ __forceinline__ XcdBarrier xcd_barrier_post(unsigned* bar, volatile LAS unsigned* st) {
    XcdBarrier b; b.bar = bar; b.x = xb_xcc_id(); b.st = st;
    if (threadIdx.x == 0) (void)xb_add(&bar[XB_XCNT(b.x)], 1u);
    return b;
}
__device__ __forceinline__ void xcd_barrier_complete(unsigned* bar, unsigned x, unsigned& nloc, unsigned& nx) {
    const unsigned G = gridDim.x * gridDim.y * gridDim.z;
    unsigned sum, cnt, mine, sp = 0u;
    for (;;) {
        sum = 0u; cnt = 0u; mine = 0u;
#pragma unroll
        for (unsigned j = 0; j < 16; ++j) { const unsigned c = xb_ld(&bar[XB_XCNT(j)]); sum += c; cnt += (c > 0u) ? 1u : 0u; mine = (j == x) ? c : mine; }
        if (sum == G) break;
        __builtin_amdgcn_s_sleep(1);
        if ((++sp & 255u) == 0u) { if (xb_ld(&bar[XB_TMO])) break; if (sp > XB_SPIN_CAP) { atomicAdd(&bar[XB_TMO], 1u); break; } }
    }
    nloc = mine > 0u ? mine : 1u; nx = cnt > 0u ? cnt : 1u;
}
__device__ __forceinline__ void xcd_barrier(const XcdBarrier& b) {
    asm volatile("s_waitcnt vmcnt(0)" ::: "memory");
    __syncthreads();
    if (threadIdx.x == 0) {
        unsigned* bar = b.bar;
        __builtin_amdgcn_s_waitcnt(0);
        unsigned nloc = b.st[0], nx = b.st[1];
        if (nloc == 0u) { xcd_barrier_complete(bar, b.x, nloc, nx); b.st[0] = nloc; b.st[1] = nx; }
        const unsigned old = xb_add(&bar[XB_XSUB(b.x)], 1u);
        const unsigned gen = old / nloc;
        if (old + 1u == (gen + 1u) * nloc) {
            __builtin_amdgcn_fence(__ATOMIC_RELEASE, "agent");
            asm volatile("s_waitcnt vmcnt(0)" ::: "memory");
            const unsigned og = xb_add(&bar[XB_TOP], 1u);
            const unsigned tg = og / nx;
            if (og + 1u == (tg + 1u) * nx) xb_add(&bar[XB_TOPGEN], 1u);
            else XB_SPIN(xb_ld(&bar[XB_TOPGEN]) == tg, bar);
            __builtin_amdgcn_fence(__ATOMIC_ACQUIRE, "agent");
            xb_add(&bar[XB_XGEN(b.x)], 1u);
            asm volatile("s_waitcnt vmcnt(0)" ::: "memory");
        } else {
            XB_SPIN(xb_ld(&bar[XB_XGEN(b.x)]) == gen, bar);
            __builtin_amdgcn_fence(__ATOMIC_ACQUIRE, "agent");
            asm volatile("s_waitcnt vmcnt(0)" ::: "memory");
        }
    }
    __syncthreads();
}

enum { T_PREP = 0, T_NORM, T_GBF, T_GSWI, T_GRES, T_MIX, T_SOFTMAX, T_FINAL };
constexpr int NSTEPS = 2 + 16 * NL + 1;
__host__ __device__ __forceinline__ void decode_step(int st, int& type, int& l, int& sub, bool& sync) {
    sync = true; l = 0; sub = 0;
    if (st == 0) { type = T_PREP; return; }
    if (st == 1) { type = T_GBF; sub = 0; return; }
    if (st == NSTEPS - 1) { type = T_FINAL; return; }
    const int r = (st - 2) & 15; l = (st - 2) >> 4;
    switch (r) {
        case 0: type = T_NORM; sub = 0; break;
        case 1: type = T_GSWI; sub = 0; break;
        case 2: type = T_GRES; sub = 0; break;
        case 3: type = T_NORM; sub = 1; break;
        case 4: type = T_GBF; sub = 1; break;
        case 5: type = T_MIX; break;
        case 6: type = T_GRES; sub = 1; break;
        case 7: type = T_NORM; sub = 2; sync = false; break;
        case 8: type = T_GBF; sub = 2; sync = false; break;
        case 9: type = T_GBF; sub = 3; break;
        case 10: type = T_GBF; sub = 4; break;
        case 11: type = T_SOFTMAX; break;
        case 12: type = T_GRES; sub = 2; break;
        case 13: type = T_NORM; sub = 3; break;
        case 14: type = T_GSWI; sub = 1; break;
        default: type = T_GRES; sub = 3; break;
    }
}

__global__ void __launch_bounds__(512, 2) fwd_kernel(Params pk) {
    extern __shared__ __attribute__((aligned(16))) unsigned char lds_raw[];
    LAS unsigned char* lds = (LAS unsigned char*)lds_raw;
    { const unsigned* ka = (const unsigned*)__builtin_amdgcn_kernarg_segment_ptr();
      if (threadIdx.x < sizeof(Params) / 4) ((LAS unsigned*)(lds + PARAM_OFF))[threadIdx.x] = ka[threadIdx.x];
      if (threadIdx.x < 2) ((LAS unsigned*)(lds + PARAM_OFF + 512))[threadIdx.x] = 0u; }
    __syncthreads();
    Ctx p; p.lds = lds;
#if MK_ONE_LAUNCH
    const XcdBarrier xbar = xcd_barrier_post((unsigned*)p.ws(), (volatile LAS unsigned*)(lds + PARAM_OFF + 512));
#endif
    const int G = gridDim.x, c = blockIdx.x;
    const int st_hi = p.hi();
    for (int st = p.lo(); st < st_hi; ++st) {
        unsigned char* ws = p.ws();
        int type, l, sub; bool sync;
        decode_step(st, type, l, sub, sync);
        const char* wl = (const char*)(ws + WS_W + (size_t)l * LAYER_W);
        if (type == T_PREP) { for (int rep = 0; rep < REP_PREP; ++rep) phase_prep(p, lds); }
        else if (type == T_NORM) {
            const float* gain = (sub == 0 ? p.in(2) : sub == 1 ? p.in(5) : sub == 2 ? p.in(18) : p.in(23)) + (size_t)l * 1024;
            const bool first = (l == 0 && sub == 0);
            for (int rep = 0; rep < REP_NORM; ++rep) phase_norm(p, first ? p.in(0) : p.out(), gain, first ? p.out() : nullptr);
        } else if (type == T_GBF) {
            pg8::Gemm g; pg8::Sched S; pg8::EpiBf16 E; S.G = G; S.c = c; S.bB = 0; E.sc = 1.0f; S.nM = 1; S.nN = 1;
            if (sub == 0) { g = {(const char*)(ws + WS_MEMN), (const char*)(ws + WS_W + W_KV), 1024, 1024, 1024}; S.kind = 2; S.nwg = 512; S.tA = 256 * 1024 * 2; S.tB = 256 * 1024 * 2; S.ldc = 2048; S.cw = 256; E.O = (bf16_t*)(ws + WS_KV); E.ldc = 2048; }
            else if (sub == 1) { g = {(const char*)(ws + WS_HN), wl + W_IN, 1024, 1024, 1024}; S.kind = 0; S.nM = 256; S.nN = 14; S.nwg = 256 * 14; S.tA = 256 * 1024 * 2; S.tB = 256 * 1024 * 2; S.ldc = DINP; S.cw = 256; E.O = (bf16_t*)(ws + WS_PROJ); E.ldc = DINP; }
            else if (sub == 2) { g = {(const char*)(ws + WS_KV + (size_t)l * 4096 * 2048 * 2), wl + W_Q, 2048, 1024, 256}; S.kind = 3; S.nwg = 256; S.tA = 0; S.tB = 0; S.ldc = 1024; S.cw = 256; E.O = (bf16_t*)(ws + WS_XM); E.ldc = 1024; }
            else if (sub == 3) { g = {wl + W_O, (const char*)(ws + WS_KV + (size_t)l * 4096 * 2048 * 2), 1024, 2048, 256}; S.kind = 4; S.nwg = 256; S.tA = 0; S.tB = 0; S.ldc = 1024; S.cw = 256; E.O = (bf16_t*)(ws + WS_XN); E.ldc = 1024; }
            else { g = {(const char*)(ws + WS_HN), (const char*)(ws + WS_XM), 1024, 1024, 1024}; S.kind = 1; S.nM = 256; S.nN = 4; S.nwg = 1024; S.tA = 256 * 1024 * 2; S.tB = 256 * 1024 * 2; S.bB = (size_t)1024 * 1024 * 2; S.ldc = 1024; S.cw = 256; E.O = (bf16_t*)(ws + WS_PROJ); E.ldc = 1024; E.sc = 0.0625f; }
            pg8::gemm_phase<pg8::EpiBf16>(lds, g, S, E);
        } else if (type == T_GSWI) {
            pg8::Gemm g = {(const char*)(ws + WS_HN), wl + (sub == 0 ? W_GU1 : W_GU2), 1024, 1024, 1024};
            pg8::Sched S; S.kind = 0; S.nM = 256; S.nN = 22; S.nwg = 256 * 22; S.G = G; S.c = c; S.ldc = FF; S.cw = 128; S.tA = 256 * 1024 * 2; S.tB = 256 * 1024 * 2; S.bB = 0;
            pg8::EpiSwi E; E.O = (bf16_t*)(ws + WS_PROJ); E.ldc = FF;
            for (int rep = 0; rep < REP_GSWI; ++rep) pg8::gemm_phase<pg8::EpiSwi>(lds, g, S, E);
        } else if (type == T_GRES) {
            pg8::Gemm g; pg8::Sched S; pg8::EpiRes E; S.kind = 0; S.nM = 256; S.nN = 4; S.nwg = 1024; S.G = G; S.c = c; S.ldc = 1024; S.cw = 256; S.bB = 0; E.X = p.out(); E.sc = 1.0f;
            if (sub == 0 || sub == 3) { g = {(const char*)(ws + WS_PROJ), wl + (sub == 0 ? W_D1 : W_D2), FF, FF, FF}; S.tA = (size_t)256 * FF * 2; S.tB = (size_t)256 * FF * 2; E.sc = 0.5f; }
            else if (sub == 1) { g = {(const char*)(ws + WS_HN), wl + W_OUT, 1024, 1024, 1024}; S.tA = 256 * 1024 * 2; S.tB = 256 * 1024 * 2; }
            else { g = {(const char*)(ws + WS_PROJ), (const char*)(ws + WS_XN), 1024, 1024, 1024}; S.kind = 1; S.tA = 256 * 1024 * 2; S.tB = 256 * 1024 * 2; S.bB = (size_t)1024 * 1024 * 2; }
            pg8::gemm_phase<pg8::EpiRes>(lds, g, S, E);
        } else if (type == T_MIX) { for (int rep = 0; rep < REP_MIX; ++rep) phase_mix(p, l, lds); }
        else if (type == T_SOFTMAX) phase_softmax(p);
        else phase_final(p);
        #if MK_ONE_LAUNCH
        if (sync && st + 1 < st_hi) { for (int rep = 0; rep < REP_SYNC; ++rep) { if (st == 0) cg::this_grid().sync(); else xcd_barrier(xbar); } }
#else
        if (sync && st + 1 < st_hi) cg::this_grid().sync();
#endif
    }
}

extern "C" void kernel_launch(void* const* d_in, const int* in_sizes, int n_in, void* d_out, int out_size, void* d_ws, size_t ws_size, hipStream_t stream) {
    static int grid = 0;
    if (grid == 0) {
        if (n_in != 27 || out_size != TT * DM || ws_size < WS_END) { fprintf(stderr, "kernel_launch: unexpected shapes (n_in %d out %d ws %zu)\n", n_in, out_size, ws_size); grid = -1; return; }
        int dev = 0, cus = 0, per_cu = 0;
        hipGetDevice(&dev); hipDeviceGetAttribute(&cus, hipDeviceAttributeMultiprocessorCount, dev);
        hipFuncSetAttribute((const void*)fwd_kernel, hipFuncAttributeMaxDynamicSharedMemorySize, LDS_BYTES);
        hipOccupancyMaxActiveBlocksPerMultiprocessor(&per_cu, (const void*)fwd_kernel, 512, LDS_BYTES);
        if (per_cu < 1) per_cu = 1;
        grid = cus * per_cu;
        (void)hipGetLastError();
    }
    if (grid < 0) return;
    Params p{};
    for (int i = 0; i < 27; ++i) p.in[i] = (const float*)d_in[i];
    p.out = (float*)d_out; p.ws = (unsigned char*)d_ws;
    for (int d = 0; d < 32; ++d) p.inv_freq[d] = powf(10000.0f, -(float)d / 32.0f);
#if MK_ONE_LAUNCH
    (void)hipMemsetAsync(d_ws, 0, 65536, stream);
    p.lo = 0; p.hi = NSTEPS;
    void* args[] = {&p};
    hipError_t e = hipLaunchCooperativeKernel((const void*)fwd_kernel, dim3(grid), dim3(512), args, LDS_BYTES, stream);
    if (e != hipSuccess) fprintf(stderr, "cooperative launch failed: %s (grid %d)\n", hipGetErrorString(e), grid);
#else
    int lo = 0;
    for (int st = 0; st < NSTEPS; ++st) {
        int type, l, sub; bool sync; decode_step(st, type, l, sub, sync);
        if (sync || st == NSTEPS - 1) { p.lo = lo; p.hi = st + 1; hipLaunchKernelGGL(fwd_kernel, dim3(grid), dim3(512), LDS_BYTES, stream, p); lo = st + 1; }
    }
#endif
}
```

```cpp
#include <hip/hip_runtime.h>
#include <hip/hip_cooperative_groups.h>
#include <cstdio>
#include <cstdint>
#include <cmath>
namespace cg = cooperative_groups;

#ifndef REP_MIX
#define REP_MIX 1
#endif
#ifndef REP_PREP
#define REP_PREP 1
#endif
#ifndef REP_SYNC
#define REP_SYNC 1
#endif
#ifndef REP_GSWI
#define REP_GSWI 1
#endif
#ifndef REP_NORM
#define REP_NORM 1
#endif
#ifndef MK_ONE_LAUNCH
#define MK_ONE_LAUNCH 1
#endif

#define LAS __attribute__((address_space(3)))
typedef unsigned short bf16_t;
typedef short bf16x8 __attribute__((ext_vector_type(8)));
typedef float f32x4 __attribute__((ext_vector_type(4)));
typedef unsigned u32x4 __attribute__((ext_vector_type(4)));
typedef unsigned u32x2 __attribute__((ext_vector_type(2)));

constexpr int TT = 65536, DM = 1024, FF = 2816, DIN = 3344, DINP = 3584, NL = 4, SEQ = 4096;
constexpr float EPS = 1e-6f;
constexpr size_t MiB = 1u << 20;
constexpr size_t WS_ROPE = 1 * MiB;
constexpr size_t WS_W = 2 * MiB, LAYER_W = 50 * MiB;
constexpr size_t W_GU1 = 0, W_D1 = 11 * MiB, W_IN = W_D1 + 5632 * 1024, W_OUT = W_IN + 7 * MiB, W_Q = W_OUT + 2 * MiB, W_KV = W_Q + 2 * MiB,
                 W_O = W_KV + 4 * MiB, W_GU2 = W_O + 2 * MiB, W_D2 = W_GU2 + 11 * MiB;
static_assert(W_D2 + 5632 * 1024 == LAYER_W, "weight map");
constexpr size_t WS_MEMN = 202 * MiB;
constexpr size_t WS_KV = 234 * MiB;
constexpr size_t WS_XB = 298 * MiB;
constexpr size_t WS_Y = 426 * MiB;
constexpr size_t WS_PROJ = 554 * MiB;
constexpr size_t WS_RSP = 1002 * MiB;
constexpr size_t WS_XM = WS_PROJ + 128 * MiB;
constexpr size_t WS_XN = WS_PROJ + 160 * MiB;
constexpr size_t WS_END = 1006 * MiB;

struct Params {
    const float* in[27];
    float* out; unsigned char* ws;
    float inv_freq[32];
    int lo, hi;
};


constexpr int LDS_BYTES = 147456;
constexpr int PARAM_OFF = LDS_BYTES - 1024;
struct Ctx {
    LAS unsigned char* lds;
    __device__ __forceinline__ unsigned long long q(int i) const { const LAS unsigned* pw = (const LAS unsigned*)(lds + PARAM_OFF) + 2 * i;
        const unsigned lo = __builtin_amdgcn_readfirstlane(pw[0]), hi = __builtin_amdgcn_readfirstlane(pw[1]); return ((unsigned long long)hi << 32) | lo; }
    __device__ __forceinline__ const float* in(int i) const { return (const float*)q(i); }
    __device__ __forceinline__ float* out() const { return (float*)q(27); }
    __device__ __forceinline__ unsigned char* ws() const { return (unsigned char*)q(28); }
    __device__ __forceinline__ float invf(int d) const { return ((const LAS float*)(lds + PARAM_OFF))[58 + d]; }
    __device__ __forceinline__ int lo() const { return __builtin_amdgcn_readfirstlane(((const LAS int*)(lds + PARAM_OFF))[90]); }
    __device__ __forceinline__ int hi() const { return __builtin_amdgcn_readfirstlane(((const LAS int*)(lds + PARAM_OFF))[91]); }
};
static_assert(sizeof(Params) == 368, "Params layout");

__device__ __forceinline__ int opaque_tid() { int t = threadIdx.x; asm volatile("" : "+v"(t)); return t; }
__device__ __forceinline__ unsigned f2bf(float f) { unsigned u = __float_as_uint(f); return (u + 0x7fffu + ((u >> 16) & 1u)) >> 16; }
__device__ __forceinline__ unsigned pk2(float lo, float hi) { return f2bf(lo) | (f2bf(hi) << 16); }
__device__ __forceinline__ float bflo(unsigned w) { return __uint_as_float(w << 16); }
__device__ __forceinline__ float bfhi(unsigned w) { return __uint_as_float(w & 0xffff0000u); }
__device__ __forceinline__ float sigmoidf_(float x) { return __builtin_amdgcn_rcpf(1.0f + __expf(-x)); }
__device__ __forceinline__ float siluf_(float x) { return x * __builtin_amdgcn_rcpf(1.0f + __expf(-x)); }
__device__ __forceinline__ float wave_sum(float v) {
#pragma unroll
    for (int o = 1; o < 64; o <<= 1) v += __shfl_xor(v, o);
    return v;
}

namespace pg8 {
constexpr int BM = 256, BK = 64, HALF = 128, HTB = HALF * BK * 2, STAGE_BYTES = 8 * HTB, NXCD = 8, WGM = 8;
__host__ __device__ __forceinline__ int lds_byte(int r, int c) { const int st = (r >> 4) * 2 + (c >> 5), rr = r & 15, cc = c & 31, ob = rr * 64 + cc * 2; return st * 1024 + (ob ^ (((ob >> 9) & 1) << 5)); }
__host__ __device__ __forceinline__ void stage_rc(int b, int& R, int& C) { const int st = b / 1024, sb = b % 1024, swz = sb ^ (((sb >> 9) & 1) << 5); R = (st >> 1) * 16 + swz / 64; C = (st & 1) * 32 + (swz % 64) / 2; }
__host__ __device__ __forceinline__ int perm32(int rho) { const int n = rho >> 4, i = rho & 15; return 8 * (i >> 2) + 4 * n + (i & 3); }

struct Unit { size_t offA, offB, offC; int row0, pn; };
struct Gemm { const char* A; const char* Bt; int lda, ldb, K; };

struct Sched {
    int kind, nM, nN, nwg, G, c, ldc, cw;
    size_t tA, tB, bB;
    __device__ __forceinline__ bool next(int i, Unit& u) const {
        const long L = (long)i * G + c; if (L >= nwg) return false;
        if (kind <= 1) {
            int wgid = (int)L; { const int q = nwg / NXCD, r = nwg % NXCD, xcd = wgid % NXCD, off = wgid / NXCD; wgid = (xcd < r ? xcd * (q + 1) : r * (q + 1) + (xcd - r) * q) + off; }
            const int nig = WGM * nN, gid = wgid / nig, fm = gid * WGM, gsz = (nM - fm) < WGM ? (nM - fm) : WGM;
            const int pm = fm + ((wgid % nig) % gsz), pn = (wgid % nig) / gsz;
            u.offA = (size_t)pm * tA; u.offB = (size_t)pn * tB + (kind == 1 ? (size_t)(pm >> 4) * bB : (size_t)0); u.offC = (size_t)pm * 256 * ldc + (size_t)pn * cw; u.row0 = pm * 256; u.pn = pn;
        } else if (kind == 2) {
            const int ll = (int)L >> 7, r = (int)L & 127, pm = r >> 3, pn = r & 7; u.row0 = 0; u.pn = 0;
            u.offA = (size_t)ll * (4096 * 1024 * 2) + (size_t)pm * tA; u.offB = (size_t)ll * LAYER_W + (size_t)pn * tB; u.offC = (size_t)ll * (4096 * 2048) + (size_t)pm * 256 * 2048 + (size_t)pn * 256;
        } else if (kind == 3) {
            const int z = (int)L >> 2, pn = (int)L & 3, b = z >> 2, h = z & 3; u.row0 = 0; u.pn = 0;
            u.offA = ((size_t)(b * 256) * 2048 + h * 256) * 2; u.offB = ((size_t)pn * 256 * 1024 + h * 256) * 2; u.offC = (size_t)b * 1024 * 1024 + (size_t)(h * 256) * 1024 + pn * 256;
        } else {
            const int z = (int)L >> 2, pm = (int)L & 3, b = z >> 2, h = z & 3; u.row0 = 0; u.pn = 0;
            u.offA = ((size_t)pm * 256 * 1024 + h * 256) * 2; u.offB = ((size_t)(b * 256) * 2048 + 1024 + h * 256) * 2; u.offC = (size_t)b * 1024 * 1024 + (size_t)(pm * 256) * 1024 + h * 256;
        }
        return true;
    }
};

__device__ __forceinline__ unsigned cvt_pk_bf16(float lo, float hi) { unsigned r; asm volatile("v_cvt_pk_bf16_f32 %0, %1, %2" : "=v"(r) : "v"(lo), "v"(hi)); return r; }

__device__ __forceinline__ float rstd_fin(const f32x4 v) { float s = (v.x + v.y) + (v.z + v.w); s += __shfl_xor(s, 16); s += __shfl_xor(s, 32); return rsqrtf(s * (1.0f / 1024.0f) + EPS); }
#define ROW_RSTD_ALL(rsp_, row0_, wr_, fr_, fq_, R) \
    float R##00, R##01, R##02, R##03, R##10, R##11, R##12, R##13; \
    { const float* _b = (rsp_) + (size_t)((row0_) + (wr_) * 64 + (fr_)) * 16 + 4 * (fq_); \
      const f32x4 _v00 = *(const f32x4*)(_b), _v01 = *(const f32x4*)(_b + 16 * 16), _v02 = *(const f32x4*)(_b + 32 * 16), _v03 = *(const f32x4*)(_b + 48 * 16); \
      const f32x4 _v10 = *(const f32x4*)(_b + 128 * 16), _v11 = *(const f32x4*)(_b + 144 * 16), _v12 = *(const f32x4*)(_b + 160 * 16), _v13 = *(const f32x4*)(_b + 176 * 16); \
      R##00 = rstd_fin(_v00); R##01 = rstd_fin(_v01); R##02 = rstd_fin(_v02); R##03 = rstd_fin(_v03); R##10 = rstd_fin(_v10); R##11 = rstd_fin(_v11); R##12 = rstd_fin(_v12); R##13 = rstd_fin(_v13); }
#define ROW_RSTD_PICK(R, ai, m) ((ai) == 0 ? ((m) == 0 ? R##00 : (m) == 1 ? R##01 : (m) == 2 ? R##02 : R##03) : ((m) == 0 ? R##10 : (m) == 1 ? R##11 : (m) == 2 ? R##12 : R##13))
struct EpiBf16 {
    static constexpr bool PERM = true;
    bf16_t* O; int ldc; float sc; const float* rsp;
    __device__ __forceinline__ void operator()(const f32x4 (&acc)[2][2][4][2], const Unit& u, int wr, int wc, int fr, int fq) const {
        bf16_t* base = O + u.offC + (size_t)(wr * 64 + fr) * ldc + wc * 32 + 8 * fq;
        const bool has = (rsp != nullptr);
        float r00 = 1.f, r01 = 1.f, r02 = 1.f, r03 = 1.f, r10 = 1.f, r11 = 1.f, r12 = 1.f, r13 = 1.f;
        if (has) { ROW_RSTD_ALL(rsp, u.row0, wr, fr, fq, rs) r00 = rs00; r01 = rs01; r02 = rs02; r03 = rs03; r10 = rs10; r11 = rs11; r12 = rs12; r13 = rs13; }
#pragma unroll
        for (int ai = 0; ai < 2; ++ai)
#pragma unroll
            for (int m = 0; m < 4; ++m) { bf16_t* rowp = base + (size_t)(ai * HALF + m * 16) * ldc; const float s = sc * ROW_RSTD_PICK(r, ai, m);
#pragma unroll
                for (int bj = 0; bj < 2; ++bj) { const f32x4 v0 = acc[ai][bj][m][0] * s, v1 = acc[ai][bj][m][1] * s;
                    u32x4 w; w.x = cvt_pk_bf16(v0[0], v0[1]); w.y = cvt_pk_bf16(v0[2], v0[3]); w.z = cvt_pk_bf16(v1[0], v1[1]); w.w = cvt_pk_bf16(v1[2], v1[3]);
                    *(u32x4*)(rowp + bj * HALF) = w; } }
    }
};
struct EpiSwi {
    static constexpr bool PERM = true;
    bf16_t* O; int ldc; const float* rsp;
    __device__ __forceinline__ void operator()(const f32x4 (&acc)[2][2][4][2], const Unit& u, int wr, int wc, int fr, int fq) const {
        bf16_t* base = O + u.offC + (size_t)(wr * 64 + fr) * ldc + wc * 32 + 8 * fq;
        ROW_RSTD_ALL(rsp, u.row0, wr, fr, fq, rs)
#pragma unroll
        for (int ai = 0; ai < 2; ++ai)
#pragma unroll
            for (int m = 0; m < 4; ++m) { bf16_t* rowp = base + (size_t)(ai * HALF + m * 16) * ldc; const float s = ROW_RSTD_PICK(rs, ai, m);
                float r[8];
#pragma unroll
                for (int n = 0; n < 2; ++n)
#pragma unroll
                    for (int e = 0; e < 4; ++e) { const float g = acc[ai][0][m][n][e] * s, up = acc[ai][1][m][n][e] * s; r[n * 4 + e] = g * __builtin_amdgcn_rcpf(1.0f + __expf(-g)) * up; }
                u32x4 w; w.x = cvt_pk_bf16(r[0], r[1]); w.y = cvt_pk_bf16(r[2], r[3]); w.z = cvt_pk_bf16(r[4], r[5]); w.w = cvt_pk_bf16(r[6], r[7]);
                *(u32x4*)rowp = w; }
    }
};
struct EpiRes {
    static constexpr bool PERM = true;
    float* X; float sc; bf16_t* XB; float* rsp;
    __device__ __forceinline__ void operator()(const f32x4 (&acc)[2][2][4][2], const Unit& u, int wr, int wc, int fr, int fq) const {
        const size_t o0 = u.offC + (size_t)(wr * 64 + fr) * 1024 + wc * 32 + 8 * fq;
        float* const __restrict__ Xl = X; bf16_t* const __restrict__ XBl = XB; float* const __restrict__ rspl = rsp; const float scl = sc;
#pragma unroll
        for (int ai = 0; ai < 2; ++ai)
#pragma unroll
            for (int mp = 0; mp < 4; mp += 2) {
                f32x4 xin[2][2][2];
#pragma unroll
                for (int mm = 0; mm < 2; ++mm)
#pragma unroll
                    for (int bj = 0; bj < 2; ++bj) { const f32x4* q = (const f32x4*)(Xl + o0 + (size_t)(ai * HALF + (mp + mm) * 16) * 1024 + bj * HALF); xin[mm][bj][0] = q[0]; xin[mm][bj][1] = q[1]; }
#pragma unroll
                for (int mm = 0; mm < 2; ++mm) { const int m = mp + mm; const size_t o = o0 + (size_t)(ai * HALF + m * 16) * 1024; float ss = 0.f;
#pragma unroll
                    for (int bj = 0; bj < 2; ++bj) { f32x4* q = (f32x4*)(Xl + o + bj * HALF);
                        const f32x4 x0 = xin[mm][bj][0] + acc[ai][bj][m][0] * scl, x1 = xin[mm][bj][1] + acc[ai][bj][m][1] * scl;
                        q[0] = x0; q[1] = x1;
                        u32x4 w; w.x = cvt_pk_bf16(x0[0], x0[1]); w.y = cvt_pk_bf16(x0[2], x0[3]); w.z = cvt_pk_bf16(x1[0], x1[1]); w.w = cvt_pk_bf16(x1[2], x1[3]);
                        *(u32x4*)(XBl + o + bj * HALF) = w;
                        ss += (x0[0] * x0[0] + x0[1] * x0[1]) + (x0[2] * x0[2] + x0[3] * x0[3]) + (x1[0] * x1[0] + x1[1] * x1[1]) + (x1[2] * x1[2] + x1[3] * x1[3]); }
                    ss += __shfl_xor(ss, 16); ss += __shfl_xor(ss, 32);
                    if (fq == 0) rspl[(size_t)(u.row0 + ai * HALF + wr * 64 + m * 16 + fr) * 16 + 4 * u.pn + wc] = ss; } }
    }
};

template <class Epi>
__device__ __forceinline__ void gemm_phase(LAS unsigned char* lds, const Gemm g, const Sched S, const Epi E) {
    const int tid = opaque_tid(), wid = __builtin_amdgcn_readfirstlane(tid >> 6), lane = tid & 63, wr = wid >> 2, wc = wid & 3, fr = lane & 15, fq = lane >> 4;
    const int K = g.K, nt = K / BK;
    unsigned voffA[2], voffB[2];
#pragma unroll
    for (int i = 0; i < 2; ++i) { int R, C; stage_rc(tid * 16 + i * 8192, R, C); const int Rb = Epi::PERM ? ((R & ~31) + perm32(R & 31)) : R;
        voffA[i] = (unsigned)(R * g.lda + C) * 2u; voffB[i] = (unsigned)(Rb * g.ldb + C) * 2u; }
    const size_t kstep = (size_t)(BK * 2);
    const size_t hstepA = (size_t)HALF * g.lda * 2, hstepB = (size_t)HALF * g.ldb * 2;
    const unsigned ldsw = (unsigned)wid * 1024u;
    const int aoff = lds_byte(wr * 64 + fr, fq * 8), boff = lds_byte(wc * 32 + fr, fq * 8);
#define PG8_SA(b, h) (((b) * 2 + (h)) * HTB)
#define PG8_SB(b, h) ((4 + (b) * 2 + (h)) * HTB)
#define PG8_STAGE(bufoff, gbase, voff) do { _Pragma("unroll") for (int _i = 0; _i < 2; ++_i) \
        __builtin_amdgcn_global_load_lds((const unsigned*)((const char*)(gbase) + (voff)[_i]), (LAS unsigned*)(lds + (bufoff) + ldsw + _i * 8192), 16, 0, 0); } while (0)
#define PG8_LDA(dst, b, h) do { _Pragma("unroll") for (int m = 0; m < 4; ++m) _Pragma("unroll") for (int k = 0; k < 2; ++k) dst[m][k] = *(const LAS bf16x8*)(lds + PG8_SA(b, h) + aoff + m * 2048 + k * 1024); } while (0)
#define PG8_LDB(dst, b, h) do { _Pragma("unroll") for (int n = 0; n < 2; ++n) _Pragma("unroll") for (int k = 0; k < 2; ++k) dst[n][k] = *(const LAS bf16x8*)(lds + PG8_SB(b, h) + boff + n * 2048 + k * 1024); } while (0)
#define PG8_MMA(ai, bj, At, Bt) do { __builtin_amdgcn_s_setprio(1); _Pragma("unroll") for (int m = 0; m < 4; ++m) _Pragma("unroll") for (int n = 0; n < 2; ++n) _Pragma("unroll") for (int k = 0; k < 2; ++k) \
        acc[ai][bj][m][n] = __builtin_amdgcn_mfma_f32_16x16x32_bf16(Bt[n][k], At[m][k], acc[ai][bj][m][n], 0, 0, 0); __builtin_amdgcn_s_setprio(0); } while (0)
#define PG8_WAIT_V(n) asm volatile("s_waitcnt vmcnt(" #n ")" ::: "memory")
#define PG8_WAIT_L(n) asm volatile("s_waitcnt lgkmcnt(" #n ")" ::: "memory")
#define PG8_BAR __builtin_amdgcn_s_barrier()
#define PG8_SCHED __builtin_amdgcn_sched_barrier(0)
    Unit cur, nxt; int ui = 0;
    if (!S.next(0, cur)) return;
    f32x4 acc[2][2][4][2];
#pragma unroll
    for (int a = 0; a < 2; ++a)
#pragma unroll
        for (int b = 0; b < 2; ++b)
#pragma unroll
            for (int m = 0; m < 4; ++m)
#pragma unroll
                for (int n = 0; n < 2; ++n) acc[a][b][m][n] = (f32x4){0.f, 0.f, 0.f, 0.f};
    bf16x8 At[4][2], B0[2][2], B1[2][2];
    const char* cA = g.A + cur.offA; const char* cB = g.Bt + cur.offB;
    PG8_STAGE(PG8_SB(0, 0), cB, voffB); PG8_STAGE(PG8_SB(0, 1), cB + hstepB, voffB); PG8_STAGE(PG8_SA(0, 0), cA, voffA); PG8_STAGE(PG8_SA(0, 1), cA + hstepA, voffA);
    if (wr == 1) PG8_BAR;
    PG8_WAIT_V(2); PG8_BAR;
    PG8_STAGE(PG8_SB(1, 0), cB + kstep, voffB); PG8_STAGE(PG8_SA(1, 0), cA + kstep, voffA); PG8_STAGE(PG8_SB(1, 1), cB + hstepB + kstep, voffB);
    PG8_WAIT_V(6); PG8_BAR;
    for (;;) {
        const bool has_next = S.next(ui + 1, nxt);
        const char* nA = has_next ? g.A + nxt.offA : cA; const char* nB = has_next ? g.Bt + nxt.offB : cB;
        for (int t = 0; t < nt; t += 2) {
            const bool last = (t == nt - 2);
            const char* a1 = cA + (size_t)(t + 1) * kstep;
            const char* a2 = last ? nA : cA + (size_t)(t + 2) * kstep; const char* b2 = last ? nB : cB + (size_t)(t + 2) * kstep;
            const char* a3 = a2 + kstep; const char* b3 = b2 + kstep;
            PG8_LDB(B0, 0, 0); PG8_LDB(B1, 0, 1); PG8_SCHED; PG8_LDA(At, 0, 0); PG8_STAGE(PG8_SA(1, 1), a1 + hstepA, voffA);
            PG8_WAIT_V(8); PG8_WAIT_L(0); PG8_BAR; PG8_MMA(0, 0, At, B0); PG8_MMA(0, 1, At, B1); PG8_BAR; PG8_SCHED;
            PG8_LDA(At, 0, 1); PG8_STAGE(PG8_SB(0, 0), b2, voffB); PG8_STAGE(PG8_SB(0, 1), b2 + hstepB, voffB); PG8_STAGE(PG8_SA(0, 0), a2, voffA);
            PG8_WAIT_V(8); PG8_WAIT_L(0); PG8_BAR; PG8_MMA(1, 0, At, B0); PG8_MMA(1, 1, At, B1); PG8_BAR; PG8_SCHED;
            PG8_LDB(B0, 1, 0); PG8_LDB(B1, 1, 1); PG8_SCHED; PG8_LDA(At, 1, 0); PG8_STAGE(PG8_SA(0, 1), a2 + hstepA, voffA);
            PG8_WAIT_V(8); PG8_WAIT_L(0); PG8_BAR; PG8_MMA(0, 0, At, B0); PG8_MMA(0, 1, At, B1); PG8_BAR; PG8_SCHED;
            PG8_LDA(At, 1, 1); PG8_STAGE(PG8_SB(1, 0), b3, voffB); PG8_STAGE(PG8_SB(1, 1), b3 + hstepB, voffB); PG8_STAGE(PG8_SA(1, 0), a3, voffA);
            PG8_WAIT_V(8); PG8_WAIT_L(0); PG8_BAR; PG8_MMA(1, 0, At, B0); PG8_MMA(1, 1, At, B1); PG8_BAR; PG8_SCHED;
        }
        if (wr == 0) PG8_BAR;
        E(acc, cur, wr, wc, fr, fq);
        if (!has_next) break;
#pragma unroll
        for (int a = 0; a < 2; ++a)
#pragma unroll
            for (int b = 0; b < 2; ++b)
#pragma unroll
                for (int m = 0; m < 4; ++m)
#pragma unroll
                    for (int n = 0; n < 2; ++n) acc[a][b][m][n] = (f32x4){0.f, 0.f, 0.f, 0.f};
        cur = nxt; cA = nA; cB = nB; ++ui;
        if (wr == 1) PG8_BAR;
    }
    PG8_WAIT_V(0);
    PG8_BAR;
#undef PG8_SA
#undef PG8_SB
#undef PG8_STAGE
#undef PG8_LDA
#undef PG8_LDB
#undef PG8_MMA
#undef PG8_WAIT_V
#undef PG8_WAIT_L
#undef PG8_BAR
#undef PG8_SCHED
}
}

__device__ __forceinline__ void transpose_item(const float* W, const float* gain, int K, int N, bf16_t* WT, int out_row0, int k0, int n0, LAS float* scr, int lane) {
    const int n = n0 + (lane & 31);
#pragma unroll 8
    for (int i = 0; i < 32; ++i) { const int kk = 2 * i + (lane >> 5); const float gg = gain ? gain[k0 + kk] : 1.0f; scr[kk * 33 + (lane & 31)] = (n < N) ? W[(size_t)(k0 + kk) * N + n] * gg : 0.f; }
    asm volatile("s_waitcnt lgkmcnt(0)" ::: "memory");
    const int c = lane & 7;
#pragma unroll
    for (int j = 0; j < 4; ++j) { const int nn = (lane >> 3) + 8 * j; const LAS float* s = scr + (8 * c) * 33 + nn;
        u32x4 o; o.x = pk2(s[0 * 33], s[1 * 33]); o.y = pk2(s[2 * 33], s[3 * 33]); o.z = pk2(s[4 * 33], s[5 * 33]); o.w = pk2(s[6 * 33], s[7 * 33]);
        *(u32x4*)(WT + (size_t)(out_row0 + nn) * K + k0 + 8 * c) = o; }
    asm volatile("s_waitcnt lgkmcnt(0)" ::: "memory");
}

__device__ __forceinline__ void rms_row(const float* xrow, const float* gain, bf16_t* orow, float* copyrow, int lane) {
    const f32x4* xr = (const f32x4*)xrow + lane; const f32x4* gr = (const f32x4*)gain + lane;
    f32x4 v[4]; float s = 0.f;
#pragma unroll
    for (int j = 0; j < 4; ++j) { v[j] = xr[64 * j]; s += (v[j].x * v[j].x + v[j].y * v[j].y) + (v[j].z * v[j].z + v[j].w * v[j].w); }
    if (copyrow) {
#pragma unroll
        for (int j = 0; j < 4; ++j) ((f32x4*)copyrow + lane)[64 * j] = v[j];
    }
    const float rstd = rsqrtf(wave_sum(s) * (1.f / 1024.f) + EPS);
    unsigned long long* o8 = (unsigned long long*)orow + lane;
#pragma unroll
    for (int j = 0; j < 4; ++j) { const f32x4 gg = gr[64 * j]; const f32x4 y = v[j] * rstd * gg;
        o8[64 * j] = (unsigned long long)pk2(y.x, y.y) | ((unsigned long long)pk2(y.z, y.w) << 32); }
}

__device__ __forceinline__ void phase_prep(const Ctx p, LAS unsigned char* lds) {
    const int tid = opaque_tid(), lane = tid & 63, wave = tid >> 6;
    const int gw = blockIdx.x * 8 + wave, NGW = gridDim.x * 8;
    LAS float* scr = (LAS float*)(lds + wave * 16384);
    constexpr int I_GU = 16 * 176, I_D = 44 * 32, I_IN = 16 * 112, I_OUT = 16 * 32, I_KV = 16 * 64, I_O = 16 * 32;
    constexpr int PER_LAYER = 2 * I_GU + 2 * I_D + I_IN + I_OUT + I_KV + I_O;
    for (int it = gw; it < NL * PER_LAYER; it += NGW) {
        const int l = it / PER_LAYER; int r = it % PER_LAYER;
        unsigned char* wl = p.ws() + WS_W + (size_t)l * LAYER_W;
        const float* W; const float* gain = nullptr; int K, N, NP; bf16_t* WT; int gu = 0;
        if (r < I_GU) { W = p.in(3) + (size_t)l * 1024 * 5632; K = 1024; N = 5632; NP = 5632; WT = (bf16_t*)(wl + W_GU1); gu = 1; gain = p.in(2) + l * 1024; }
        else if ((r -= I_GU) < I_GU) { W = p.in(24) + (size_t)l * 1024 * 5632; K = 1024; N = 5632; NP = 5632; WT = (bf16_t*)(wl + W_GU2); gu = 1; gain = p.in(23) + l * 1024; }
        else if ((r -= I_GU) < I_D) { W = p.in(4) + (size_t)l * 2816 * 1024; K = 2816; N = 1024; NP = 1024; WT = (bf16_t*)(wl + W_D1); }
        else if ((r -= I_D) < I_D) { W = p.in(25) + (size_t)l * 2816 * 1024; K = 2816; N = 1024; NP = 1024; WT = (bf16_t*)(wl + W_D2); }
        else if ((r -= I_D) < I_IN) { W = p.in(6) + (size_t)l * 1024 * DIN; K = 1024; N = DIN; NP = DINP; WT = (bf16_t*)(wl + W_IN); gain = p.in(5) + l * 1024; }
        else if ((r -= I_IN) < I_OUT) { W = p.in(7) + (size_t)l * 1024 * 1024; K = 1024; N = 1024; NP = 1024; WT = (bf16_t*)(wl + W_OUT); }
        else if ((r -= I_OUT) < I_KV) { W = p.in(21) + (size_t)l * 1024 * 2048; K = 1024; N = 2048; NP = 2048; WT = (bf16_t*)(wl + W_KV); }
        else { r -= I_KV; W = p.in(22) + (size_t)l * 1024 * 1024; K = 1024; N = 1024; NP = 1024; WT = (bf16_t*)(wl + W_O); }
        const int nblk = NP / 32, kb = r / nblk, nb = r % nblk, n0 = nb * 32;
        int orow = n0;
        if (gu) { const int f = (n0 < 2816) ? n0 : n0 - 2816; orow = (f >> 7) * 256 + (f & 127) + ((n0 < 2816) ? 0 : 128); }
        transpose_item(W, gain, K, N, WT, orow, kb * 64, n0, scr, lane);
    }
    const int gt = blockIdx.x * 512 + tid, NGT = gridDim.x * 512;
    for (int i = gt; i < NL * 1024 * 1024 / 4; i += NGT) {
        const int l = i / (1024 * 1024 / 4), e = i % (1024 * 1024 / 4);
        const f32x4 v = ((const f32x4*)(p.in(20) + (size_t)l * 1024 * 1024))[e] * p.in(18)[l * 1024 + (e >> 8)];
        u32x2 o; o.x = pk2(v.x, v.y); o.y = pk2(v.z, v.w);
        ((u32x2*)(p.ws() + WS_W + (size_t)l * LAYER_W + W_Q))[e] = o;
    }
    float* rc = (float*)(p.ws() + WS_ROPE); float* rs = rc + 4096 * 32;
    for (int i = gt; i < 4096 * 32; i += NGT) {
        const int s = i >> 5, d = i & 31;
        const float ang = (float)s * p.invf(d);
        const float n = rintf(ang * 0.15915494309189535f);
        float r = fmaf(-n, 6.2831854820251465f, ang); r = fmaf(-n, -1.7484555e-07f, r);
        rc[i] = cosf(r); rs[i] = sinf(r);
    }
    for (int m = gw; m < NL * 4096; m += NGW) { const int l = m >> 12, rr = m & 4095;
        rms_row(p.in(1) + (size_t)rr * 1024, p.in(19) + l * 1024, (bf16_t*)(p.ws() + WS_MEMN) + (size_t)m * 1024, nullptr, lane); }
}

__device__ __forceinline__ void phase_init(const Ctx p) {
    const int tid_ = opaque_tid(), lane = tid_ & 63, wave = tid_ >> 6;
    const int gw = blockIdx.x * 8 + wave, NGW = gridDim.x * 8;
    const float* x = p.in(0); float* out = p.out(); bf16_t* xb = (bf16_t*)(p.ws() + WS_XB); float* rsp = (float*)(p.ws() + WS_RSP);
    for (int m = gw; m < TT; m += NGW) {
        const f32x4* xr = (const f32x4*)(x + (size_t)m * 1024) + lane; f32x4* orow = (f32x4*)(out + (size_t)m * 1024) + lane;
        unsigned long long* o8 = (unsigned long long*)(xb + (size_t)m * 1024) + lane;
        float s = 0.f;
#pragma unroll
        for (int j = 0; j < 4; ++j) { const f32x4 v = xr[64 * j]; s += (v.x * v.x + v.y * v.y) + (v.z * v.z + v.w * v.w); orow[64 * j] = v;
            o8[64 * j] = (unsigned long long)pk2(v.x, v.y) | ((unsigned long long)pk2(v.z, v.w) << 32); }
        s = wave_sum(s);
        if (lane < 16) rsp[(size_t)m * 16 + lane] = (lane == 0) ? s : 0.f;
    }
}

__device__ __forceinline__ void phase_final(const Ctx p) {
    const int tid_ = opaque_tid(), lane = tid_ & 63, wave = tid_ >> 6;
    const int gw = blockIdx.x * 8 + wave, NGW = gridDim.x * 8;
    const f32x4* gr = (const f32x4*)p.in(26) + lane;
    for (int m = gw; m < TT; m += NGW) {
        f32x4* xr = (f32x4*)(p.out() + (size_t)m * 1024) + lane;
        f32x4 v[4]; float s = 0.f;
#pragma unroll
        for (int j = 0; j < 4; ++j) { v[j] = xr[64 * j]; s += (v[j].x * v[j].x + v[j].y * v[j].y) + (v[j].z * v[j].z + v[j].w * v[j].w); }
        const float rstd = rsqrtf(wave_sum(s) * (1.f / 1024.f) + EPS);
#pragma unroll
        for (int j = 0; j < 4; ++j) xr[64 * j] = v[j] * rstd * gr[64 * j];
    }
}

__device__ __forceinline__ void phase_softmax(const Ctx p) {
    const int tid_ = opaque_tid(), lane = tid_ & 63, wave = tid_ >> 6;
    const int gw = blockIdx.x * 8 + wave, NGW = gridDim.x * 8;
    bf16_t* S = (bf16_t*)(p.ws() + WS_PROJ);
    for (int m = gw; m < TT; m += NGW) {
        u32x4* rp = (u32x4*)(S + (size_t)m * 1024) + lane * 2;
        const u32x4 w0 = rp[0], w1 = rp[1];
        float v[16];
        v[0] = bflo(w0.x); v[1] = bfhi(w0.x); v[2] = bflo(w0.y); v[3] = bfhi(w0.y); v[4] = bflo(w0.z); v[5] = bfhi(w0.z); v[6] = bflo(w0.w); v[7] = bfhi(w0.w);
        v[8] = bflo(w1.x); v[9] = bfhi(w1.x); v[10] = bflo(w1.y); v[11] = bfhi(w1.y); v[12] = bflo(w1.z); v[13] = bfhi(w1.z); v[14] = bflo(w1.w); v[15] = bfhi(w1.w);
        float mx = v[0];
#pragma unroll
        for (int i = 1; i < 16; ++i) mx = fmaxf(mx, v[i]);
#pragma unroll
        for (int o = 1; o < 16; o <<= 1) mx = fmaxf(mx, __shfl_xor(mx, o));
        float sum = 0.f;
#pragma unroll
        for (int i = 0; i < 16; ++i) { v[i] = __expf(v[i] - mx); sum += v[i]; }
#pragma unroll
        for (int o = 1; o < 16; o <<= 1) sum += __shfl_xor(sum, o);
        const float inv = 1.0f / sum;
        u32x4 o0, o1;
        o0.x = pk2(v[0] * inv, v[1] * inv); o0.y = pk2(v[2] * inv, v[3] * inv); o0.z = pk2(v[4] * inv, v[5] * inv); o0.w = pk2(v[6] * inv, v[7] * inv);
        o1.x = pk2(v[8] * inv, v[9] * inv); o1.y = pk2(v[10] * inv, v[11] * inv); o1.z = pk2(v[12] * inv, v[13] * inv); o1.w = pk2(v[14] * inv, v[15] * inv);
        rp[0] = o0; rp[1] = o1;
    }
}

constexpr int PQ = 68;
constexpr int PB = 72;
constexpr int ARRB = 64 * PB * 2;
constexpr int M_QP = 0, M_QN = M_QP + ARRB, M_KN = M_QN + ARRB, M_KP = M_KN + ARRB, M_KNT = M_KP + ARRB, M_VT = M_KNT + ARRB, M_SC = M_VT + ARRB, M_STT = M_SC + ARRB,
              M_G = M_STT + ARRB, M_SEG = M_G + 64 * PQ * 4, M_CL = M_SEG + 8 * 64 * 4, M_RF = M_CL + 256, M_W2 = M_RF + 256, M_BA = M_W2 + 2048, M_END = M_BA + 128;
static_assert(M_END <= PARAM_OFF, "mixer LDS");
#define LBAR() do { asm volatile("s_waitcnt lgkmcnt(0)" ::: "memory"); __builtin_amdgcn_s_barrier(); asm volatile("" ::: "memory"); } while (0)

__device__ __forceinline__ void unpack8(const u32x4 w, float (&f)[8]) {
    f[0] = bflo(w.x); f[1] = bfhi(w.x); f[2] = bflo(w.y); f[3] = bfhi(w.y); f[4] = bflo(w.z); f[5] = bfhi(w.z); f[6] = bflo(w.w); f[7] = bfhi(w.w);
}
__device__ __forceinline__ bf16x8 ldfrag(LAS unsigned char* arr, int r0, int k0, int lane) {
    return *(const LAS bf16x8*)(arr + (((r0 + (lane & 15)) * PB + k0 + ((lane >> 4) << 3)) << 1));
}
__device__ __forceinline__ void st4bf(LAS unsigned char* arr, int r, int c, float a, float b, float c2, float d) {
    u32x2 w; w.x = pk2(a, b); w.y = pk2(c2, d); *(LAS u32x2*)(arr + ((r * PB + c) << 1)) = w;
}
__device__ __forceinline__ void st1bf(LAS unsigned char* arr, int r, int c, float a) { *(LAS unsigned short*)(arr + ((r * PB + c) << 1)) = (unsigned short)f2bf(a); }
#define MFMA16(a, b, c) __builtin_amdgcn_mfma_f32_16x16x32_bf16((a), (b), (c), 0, 0, 0)

template <int MIX>
__device__ __forceinline__ void mix_load(const bf16_t* pr, const float* rope, int h, int cgp, u32x4& r0, u32x4& r1, u32x4& r2, u32x4& r3, u32x4& rv) {
    if constexpr (MIX == 0) {
        rv = *(const u32x4*)(pr + 512 + h * 64 + cgp * 8);
        const u32x2 a = *(const u32x2*)(pr + h * 64 + 4 * cgp), b = *(const u32x2*)(pr + h * 64 + 32 + 4 * cgp);
        const u32x2 c = *(const u32x2*)(pr + 256 + h * 64 + 4 * cgp), d = *(const u32x2*)(pr + 256 + h * 64 + 32 + 4 * cgp);
        r0 = (u32x4){a.x, a.y, b.x, b.y}; r1 = (u32x4){c.x, c.y, d.x, d.y};
        r2 = *(const u32x4*)(rope + 4 * cgp); r3 = *(const u32x4*)(rope + 4096 * 32 + 4 * cgp);
    } else if constexpr (MIX == 2) {
        rv = *(const u32x4*)(pr + 1792 + h * 64 + cgp * 8);
        const u32x2 a = *(const u32x2*)(pr + 1536 + h * 32 + 4 * cgp), b = *(const u32x2*)(pr + 1664 + h * 32 + 4 * cgp);
        r0 = (u32x4){a.x, a.y, b.x, b.y}; r1 = *(const u32x4*)(pr + 2048); r2 = *(const u32x4*)(pr + 2056); r3 = r2;
    } else {
        rv = *(const u32x4*)(pr + 2832 + h * 64 + cgp * 8);
        r0 = *(const u32x4*)(pr + 2320 + h * 64 + 8 * cgp); r1 = *(const u32x4*)(pr + 2576 + h * 64 + 8 * cgp); r2 = r1; r3 = r1;
    }
}

template <int MIX>
__device__ __forceinline__ void gla_chain(const Ctx p, int l, int b, int h, LAS unsigned char* lds) {
    constexpr int DK = (MIX == 2) ? 32 : 64;
    constexpr bool CAUSAL = (MIX == 3);
    constexpr int NE = DK / 8, NG = NE / 4, KS = DK / 32;
    constexpr int GOFF = MIX == 0 ? 768 : (MIX == 2 ? 2064 : 3088);
    constexpr int YOFF = MIX == 0 ? 0 : (MIX == 2 ? 512 : 768);
    const int tid = opaque_tid(), lane = tid & 63, w = __builtin_amdgcn_readfirstlane(tid >> 6), row = tid >> 3, cgp = tid & 7, quad = lane >> 4, l15 = lane & 15;
    LAS unsigned char* QP = lds + M_QP; LAS unsigned char* QN = lds + M_QN; LAS unsigned char* KN = lds + M_KN; LAS unsigned char* KP = lds + M_KP;
    LAS unsigned char* KNT = lds + M_KNT; LAS unsigned char* VT = lds + M_VT; LAS unsigned char* SC = lds + M_SC; LAS unsigned char* STT = lds + M_STT;
    LAS float* G = (LAS float*)(lds + M_G); LAS float* SEG = (LAS float*)(lds + M_SEG); LAS float* CL = (LAS float*)(lds + M_CL); LAS float* RF = (LAS float*)(lds + M_RF);
    LAS float* W2 = (LAS float*)(lds + M_W2); LAS float* BA = (LAS float*)(lds + M_BA);
    const bf16_t* proj = (const bf16_t*)(p.ws() + WS_PROJ) + (size_t)b * SEQ * DINP;
    bf16_t* Y = (bf16_t*)(p.ws() + WS_Y) + (size_t)b * SEQ * 1024;
    const float* rope = (const float*)(p.ws() + WS_ROPE);
    const int gb0 = (MIX == 3) ? 8 * cgp : 4 * cgp, gb1 = (MIX == 0) ? 32 + 4 * cgp : 8 * cgp + 4;
    f32x4 S[4];
#pragma unroll
    for (int i = 0; i < 4; ++i) S[i] = (f32x4){0.f, 0.f, 0.f, 0.f};
    float lbv[8];
#pragma unroll
    for (int i = 0; i < 8; ++i) lbv[i] = 0.f;
    float lg = 0.f;
    if constexpr (MIX == 0) lg = log1pf(-exp2f(-5.0f - (float)h));
    LBAR();
    if constexpr (MIX == 2) {
        const float* w2 = p.in(15) + (size_t)l * 16 * 128; const float* ba = p.in(16) + (size_t)l * 128;
        { const int r = tid >> 5, d = tid & 31; W2[r * 32 + d] = w2[r * 128 + h * 32 + d]; }
        if (tid < 32) BA[tid] = ba[h * 32 + tid];
    }
    if constexpr (MIX == 3) {
        const float* lg4 = p.in(17);
#pragma unroll
        for (int i = 0; i < 8; ++i) { const int ch = h * 64 + cgp * 8 + i;
            const float a0 = lg4[ch], a1 = lg4[256 + ch], a2 = lg4[512 + ch], a3 = lg4[768 + ch];
            const float mx = fmaxf(fmaxf(a0, a1), fmaxf(a2, a3));
            const float e0 = expf(a0 - mx), e1 = expf(a1 - mx), e2 = expf(a2 - mx), e3 = expf(a3 - mx);
            const float inv = 1.0f / (e0 + e1 + e2 + e3);
            float lb = 0.f; if (l >= 1) lb += e1 * inv; if (l >= 2) lb += e2 * inv; if (l >= 3) lb += e3 * inv;
            lbv[i] = lb; }
    }
    u32x4 r0, r1, r2, r3, rv;
    mix_load<MIX>(proj + (size_t)row * DINP, rope + (size_t)row * 32, h, cgp, r0, r1, r2, r3, rv);
    for (int c = 0; c < 64; ++c) {
        LBAR();
        const int t0 = c * 64;
        u32x2 gt[4];
        if (w < 4) {
#pragma unroll
            for (int et = 0; et < 4; ++et) gt[et] = *(const u32x2*)(proj + (size_t)(t0 + 16 * w + l15) * DINP + GOFF + h * 64 + 16 * et + 4 * quad);
        }
        float q[NE], k[NE], g[NE];
        { float vv[8]; unpack8(rv, vv);
#pragma unroll
          for (int i = 0; i < 8; ++i) st1bf(VT, cgp * 8 + i, row, vv[i]); }
        if constexpr (MIX == 0) {
            const float q1[4] = {bflo(r0.x), bfhi(r0.x), bflo(r0.y), bfhi(r0.y)}, q2[4] = {bflo(r0.z), bfhi(r0.z), bflo(r0.w), bfhi(r0.w)};
            const float k1[4] = {bflo(r1.x), bfhi(r1.x), bflo(r1.y), bfhi(r1.y)}, k2[4] = {bflo(r1.z), bfhi(r1.z), bflo(r1.w), bfhi(r1.w)};
            const float cs[4] = {__uint_as_float(r2.x), __uint_as_float(r2.y), __uint_as_float(r2.z), __uint_as_float(r2.w)};
            const float sn[4] = {__uint_as_float(r3.x), __uint_as_float(r3.y), __uint_as_float(r3.z), __uint_as_float(r3.w)};
#pragma unroll
            for (int i = 0; i < 4; ++i) { q[i] = q1[i] * cs[i] - q2[i] * sn[i]; q[4 + i] = q1[i] * sn[i] + q2[i] * cs[i];
                k[i] = (k1[i] * cs[i] - k2[i] * sn[i]) * 0.125f; k[4 + i] = (k1[i] * sn[i] + k2[i] * cs[i]) * 0.125f; g[i] = lg; g[4 + i] = lg; }
        } else if constexpr (MIX == 2) {
            const float qq[4] = {bflo(r0.x), bfhi(r0.x), bflo(r0.y), bfhi(r0.y)}, kk[4] = {bflo(r0.z), bfhi(r0.z), bflo(r0.w), bfhi(r0.w)};
            float al[16];
            { float t8[8]; unpack8(r1, t8);
#pragma unroll
              for (int i = 0; i < 8; ++i) al[i] = t8[i];
              unpack8(r2, t8);
#pragma unroll
              for (int i = 0; i < 8; ++i) al[8 + i] = t8[i]; }
#pragma unroll
            for (int i = 0; i < 4; ++i) {
                float a = BA[gb0 + i];
#pragma unroll
                for (int r = 0; r < 16; ++r) a += al[r] * W2[r * 32 + gb0 + i];
                const float ls = -(fmaxf(-a, 0.f) + __logf(1.0f + __expf(-fabsf(a))));
                q[i] = qq[i] * 0.17677669529663687f; k[i] = kk[i]; g[i] = ls * 0.0625f; }
        } else {
            float qq[8], ff[8]; unpack8(r0, qq); unpack8(r1, ff);
#pragma unroll
            for (int i = 0; i < 8; ++i) {
                const float sg = __builtin_amdgcn_rcpf(1.0f + __expf(-ff[i])), nsg = 1.0f - sg;
                q[i] = siluf_(qq[i]); k[i] = (1.0f - lbv[i]) * nsg; g[i] = __logf(lbv[i] + (1.0f - lbv[i]) * sg); }
        }
#pragma unroll
        for (int gq = 0; gq < NG; ++gq) { const int db = gq ? gb1 : gb0; *(LAS f32x4*)(G + row * PQ + db) = (f32x4){g[4 * gq], g[4 * gq + 1], g[4 * gq + 2], g[4 * gq + 3]}; }
        if (c < 63) mix_load<MIX>(proj + (size_t)(t0 + 64 + row) * DINP, rope + (size_t)(t0 + 64 + row) * 32, h, cgp, r0, r1, r2, r3, rv);
        LBAR();
        const int seg = tid / DK, sd = tid % DK;
        if (tid < 8 * DK) { float cum = 0.f;
#pragma unroll
            for (int r = 0; r < 8; ++r) { cum += G[(8 * seg + r) * PQ + sd]; G[(8 * seg + r) * PQ + sd] = cum; }
            SEG[seg * 64 + sd] = cum; }
        LBAR();
        if (tid < 8 * DK) { float off = 0.f;
#pragma unroll
            for (int s = 0; s < 7; ++s) off += (s < seg) ? SEG[s * 64 + sd] : 0.f;
            float last = 0.f;
#pragma unroll
            for (int r = 0; r < 8; ++r) { last = G[(8 * seg + r) * PQ + sd] + off; G[(8 * seg + r) * PQ + sd] = last; }
            if (seg == 3) RF[sd] = last;
            if (seg == 7) CL[sd] = last; }
        LBAR();
#pragma unroll
        for (int gq = 0; gq < NG; ++gq) { const int db = gq ? gb1 : gb0;
            const f32x4 cv = *(const LAS f32x4*)(G + row * PQ + db), rf = *(const LAS f32x4*)(RF + db);
            float e1[4], e2[4];
#pragma unroll
            for (int i = 0; i < 4; ++i) { e1[i] = __expf(cv[i] - rf[i]); e2[i] = __expf(rf[i] - cv[i]); }
            st4bf(QP, row, db, q[4 * gq] * e1[0], q[4 * gq + 1] * e1[1], q[4 * gq + 2] * e1[2], q[4 * gq + 3] * e1[3]);
            st4bf(KN, row, db, k[4 * gq] * e2[0], k[4 * gq + 1] * e2[1], k[4 * gq + 2] * e2[2], k[4 * gq + 3] * e2[3]);
#pragma unroll
            for (int i = 0; i < 4; ++i) st1bf(KNT, db + i, row, k[4 * gq + i] * e2[i]);
            if constexpr (!CAUSAL) {
                st4bf(QN, row, db, q[4 * gq] * e2[0], q[4 * gq + 1] * e2[1], q[4 * gq + 2] * e2[2], q[4 * gq + 3] * e2[3]);
                st4bf(KP, row, db, k[4 * gq] * e1[0], k[4 * gq + 1] * e1[1], k[4 * gq + 2] * e1[2], k[4 * gq + 3] * e1[3]); } }
        if (w >= 4 && (w - 4) < DK / 16) { const int dd = 16 * (w - 4) + 4 * quad; const f32x4 rf = *(const LAS f32x4*)(RF + dd);
            const float x0 = __expf(rf[0]), x1 = __expf(rf[1]), x2 = __expf(rf[2]), x3 = __expf(rf[3]);
#pragma unroll
            for (int et = 0; et < 4; ++et) st4bf(STT, 16 * et + l15, dd, x0 * S[et][0], x1 * S[et][1], x2 * S[et][2], x3 * S[et][3]); }
        LBAR();
        {
            const int j0 = 16 * (w >> 1);
            bf16x8 bqp[KS], bqn[KS];
#pragma unroll
            for (int ks = 0; ks < KS; ++ks) { bqp[ks] = ldfrag(QP, j0, 32 * ks, lane); if constexpr (!CAUSAL) bqn[ks] = ldfrag(QN, j0, 32 * ks, lane); else bqn[ks] = bqp[ks]; }
#pragma unroll
            for (int tc = 0; tc < 2; ++tc) { const int m0 = 16 * (2 * (w & 1) + tc);
                f32x4 lo = (f32x4){0.f, 0.f, 0.f, 0.f}, up = lo;
#pragma unroll
                for (int ks = 0; ks < KS; ++ks) { lo = MFMA16(ldfrag(KN, m0, 32 * ks, lane), bqp[ks], lo);
                    if constexpr (!CAUSAL) up = MFMA16(ldfrag(KP, m0, 32 * ks, lane), bqn[ks], up); }
                const int j = j0 + l15, m = m0 + 4 * quad;
                float v[4];
#pragma unroll
                for (int i = 0; i < 4; ++i) v[i] = (m + i <= j) ? lo[i] : (CAUSAL ? 0.f : up[i]);
                st4bf(SC, j, m, v[0], v[1], v[2], v[3]); }
        }
        LBAR();
        if (w < 4) {
            const int j0 = 16 * w;
            bf16x8 bsc[2], bq[KS];
            bsc[0] = ldfrag(SC, j0, 0, lane); bsc[1] = ldfrag(SC, j0, 32, lane);
#pragma unroll
            for (int ks = 0; ks < KS; ++ks) bq[ks] = ldfrag(QP, j0, 32 * ks, lane);
            f32x4 o[4];
#pragma unroll
            for (int et = 0; et < 4; ++et) { f32x4 a = (f32x4){0.f, 0.f, 0.f, 0.f};
                a = MFMA16(ldfrag(VT, 16 * et, 0, lane), bsc[0], a); a = MFMA16(ldfrag(VT, 16 * et, 32, lane), bsc[1], a);
#pragma unroll
                for (int ks = 0; ks < KS; ++ks) a = MFMA16(ldfrag(STT, 16 * et, 32 * ks, lane), bq[ks], a);
                o[et] = a; }
            float s = 0.f;
#pragma unroll
            for (int et = 0; et < 4; ++et) s += (o[et][0] + o[et][1]) + (o[et][2] + o[et][3]);
            s += __shfl_xor(s, 16); s += __shfl_xor(s, 32);
            const float mu = s * (1.0f / 64.0f);
            float qv = 0.f;
#pragma unroll
            for (int et = 0; et < 4; ++et) { o[et] = o[et] - mu; qv += (o[et][0] * o[et][0] + o[et][1] * o[et][1]) + (o[et][2] * o[et][2] + o[et][3] * o[et][3]); }
            qv += __shfl_xor(qv, 16); qv += __shfl_xor(qv, 32);
            const float rstd = rsqrtf(qv * (1.0f / 64.0f) + EPS);
            bf16_t* yr = Y + (size_t)(t0 + j0 + l15) * 1024 + YOFF + h * 64 + 4 * quad;
#pragma unroll
            for (int et = 0; et < 4; ++et) { const float g0 = bflo(gt[et].x), g1 = bfhi(gt[et].x), g2 = bflo(gt[et].y), g3 = bfhi(gt[et].y);
                u32x2 wv; wv.x = pk2(siluf_(g0) * o[et][0] * rstd, siluf_(g1) * o[et][1] * rstd); wv.y = pk2(siluf_(g2) * o[et][2] * rstd, siluf_(g3) * o[et][3] * rstd);
                *(u32x2*)(yr + 16 * et) = wv; }
        } else if ((w - 4) < DK / 16) {
            const int d0 = 16 * (w - 4);
            const bf16x8 a0 = ldfrag(KNT, d0, 0, lane), a1 = ldfrag(KNT, d0, 32, lane);
            const f32x4 cl = *(const LAS f32x4*)(CL + d0 + 4 * quad), rf = *(const LAS f32x4*)(RF + d0 + 4 * quad);
            f32x4 ec, ef;
#pragma unroll
            for (int i = 0; i < 4; ++i) { ec[i] = __expf(cl[i]); ef[i] = __expf(cl[i] - rf[i]); }
#pragma unroll
            for (int et = 0; et < 4; ++et) { f32x4 a = (f32x4){0.f, 0.f, 0.f, 0.f};
                a = MFMA16(a0, ldfrag(VT, 16 * et, 0, lane), a); a = MFMA16(a1, ldfrag(VT, 16 * et, 32, lane), a);
                S[et] = ec * S[et] + ef * a; }
        }
    }
    LBAR();
}

constexpr int R_XB = 0, R_XCF = 17408, R_XCB = R_XCF + 64 * PQ * 4, R_WAT = R_XCB + ARRB, R_WXT = R_WAT + ARRB, R_AA = R_WXT + ARRB, R_UU = R_AA + 16384, R_CW = R_UU + 16384,
              R_CB = R_CW + 1024, R_BA = R_CB + 256, R_BX = R_BA + 256, R_LS = R_BX + 256, R_END = R_LS + 256;
static_assert(R_END <= PARAM_OFF, "lru LDS");

__device__ __forceinline__ void lru_chain(const Ctx p, int l, int b, int n, LAS unsigned char* lds) {
    const int tid = opaque_tid(), lane = tid & 63, w = __builtin_amdgcn_readfirstlane(tid >> 6), row = tid >> 3, cgp = tid & 7, quad = lane >> 4, l15 = lane & 15;
    LAS float* XB = (LAS float*)(lds + R_XB); LAS float* XCF = (LAS float*)(lds + R_XCF); LAS unsigned char* XCB = lds + R_XCB; LAS unsigned char* WAT = lds + R_WAT; LAS unsigned char* WXT = lds + R_WXT;
    LAS float* AA = (LAS float*)(lds + R_AA); LAS float* UU = (LAS float*)(lds + R_UU); LAS float* CW = (LAS float*)(lds + R_CW); LAS float* CB = (LAS float*)(lds + R_CB);
    LAS float* BAv = (LAS float*)(lds + R_BA); LAS float* BXv = (LAS float*)(lds + R_BX); LAS float* LS = (LAS float*)(lds + R_LS);
    const bf16_t* proj = (const bf16_t*)(p.ws() + WS_PROJ) + (size_t)b * SEQ * DINP;
    bf16_t* Y = (bf16_t*)(p.ws() + WS_Y) + (size_t)b * SEQ * 1024;
    LBAR();
    { const float* wa = p.in(10) + ((size_t)l * 4 + n) * 4096; const float* wx = p.in(12) + ((size_t)l * 4 + n) * 4096;
#pragma unroll
      for (int i = 0; i < 8; ++i) { const int idx = tid + 512 * i, d = idx >> 6, e = idx & 63; st1bf(WAT, e, d, wa[idx]); st1bf(WXT, e, d, wx[idx]); }
      if (tid < 256) CW[tid] = p.in(8)[(size_t)l * 1024 + (tid >> 6) * 256 + n * 64 + (tid & 63)];
      if (tid < 64) { const int ch = n * 64 + tid; CB[tid] = p.in(9)[(size_t)l * 256 + ch]; BAv[tid] = p.in(11)[(size_t)l * 256 + ch]; BXv[tid] = p.in(13)[(size_t)l * 256 + ch];
          const float lam = p.in(14)[(size_t)l * 256 + ch]; LS[tid] = -8.0f * (fmaxf(-lam, 0.f) + log1pf(expf(-fabsf(lam)))); }
      if (tid < 192) XB[tid] = 0.f; }
    float hreg = 0.f;
    u32x4 xr = *(const u32x4*)(proj + (size_t)row * DINP + 1024 + n * 64 + cgp * 8);
    for (int c = 0; c < 64; ++c) {
        LBAR();
        const int t0 = c * 64;
        const u32x4 gr = *(const u32x4*)(proj + (size_t)(t0 + row) * DINP + 1280 + n * 64 + cgp * 8);
        float xv[8]; unpack8(xr, xv);
#pragma unroll
        for (int i = 0; i < 8; ++i) XB[(row + 3) * 64 + cgp * 8 + i] = xv[i];
        if (c < 63) xr = *(const u32x4*)(proj + (size_t)(t0 + 64 + row) * DINP + 1024 + n * 64 + cgp * 8);
        LBAR();
        { float xc[8];
#pragma unroll
          for (int i = 0; i < 8; ++i) { const int ch = cgp * 8 + i;
              xc[i] = CB[ch] + CW[ch] * XB[row * 64 + ch] + CW[64 + ch] * XB[(row + 1) * 64 + ch] + CW[128 + ch] * XB[(row + 2) * 64 + ch] + CW[192 + ch] * XB[(row + 3) * 64 + ch]; }
          *(LAS f32x4*)(XCF + row * PQ + cgp * 8) = (f32x4){xc[0], xc[1], xc[2], xc[3]}; *(LAS f32x4*)(XCF + row * PQ + cgp * 8 + 4) = (f32x4){xc[4], xc[5], xc[6], xc[7]};
          u32x4 wv; wv.x = pk2(xc[0], xc[1]); wv.y = pk2(xc[2], xc[3]); wv.z = pk2(xc[4], xc[5]); wv.w = pk2(xc[6], xc[7]);
          *(LAS u32x4*)(XCB + ((row * PB + cgp * 8) << 1)) = wv; }
        LBAR();
        if (row >= 61) {
#pragma unroll
            for (int i = 0; i < 8; ++i) XB[(row - 61) * 64 + cgp * 8 + i] = xv[i]; }
        {
            const int tt = 16 * (w >> 1);
            const bf16x8 b0 = ldfrag(XCB, tt, 0, lane), b1 = ldfrag(XCB, tt, 32, lane);
#pragma unroll
            for (int tc = 0; tc < 2; ++tc) { const int e0 = 16 * (2 * (w & 1) + tc);
                f32x4 ar = (f32x4){0.f, 0.f, 0.f, 0.f}, ai = ar;
                ar = MFMA16(ldfrag(WAT, e0, 0, lane), b0, ar); ar = MFMA16(ldfrag(WAT, e0, 32, lane), b1, ar);
                ai = MFMA16(ldfrag(WXT, e0, 0, lane), b0, ai); ai = MFMA16(ldfrag(WXT, e0, 32, lane), b1, ai);
                const int t = tt + l15, e4 = e0 + 4 * quad;
                const f32x4 ba = *(const LAS f32x4*)(BAv + e4), bx = *(const LAS f32x4*)(BXv + e4), ls = *(const LAS f32x4*)(LS + e4), xc = *(const LAS f32x4*)(XCF + t * PQ + e4);
                f32x4 av, uv;
#pragma unroll
                for (int i = 0; i < 4; ++i) { const float r = sigmoidf_(ar[i] + ba[i]), ig = sigmoidf_(ai[i] + bx[i]);
                    const float la = r * ls[i]; av[i] = __expf(la); uv[i] = __builtin_amdgcn_sqrtf(fmaxf(-expm1f(2.0f * la), 0.f)) * (ig * xc[i]); }
                *(LAS f32x4*)(AA + t * 64 + e4) = av; *(LAS f32x4*)(UU + t * 64 + e4) = uv; }
        }
        LBAR();
        if (tid < 64) {
#pragma unroll 16
            for (int t = 0; t < 64; ++t) { hreg = AA[t * 64 + tid] * hreg + UU[t * 64 + tid]; UU[t * 64 + tid] = hreg; } }
        LBAR();
        { float gv[8]; unpack8(gr, gv);
          float o[8];
#pragma unroll
          for (int i = 0; i < 8; ++i) { const float x = gv[i], z = 0.7978845608028654f * (x + 0.044715f * x * x * x);
              const float th = 1.0f - 2.0f * __builtin_amdgcn_rcpf(1.0f + __expf(2.0f * z)); o[i] = UU[row * 64 + cgp * 8 + i] * 0.5f * x * (1.0f + th); }
          u32x4 wv; wv.x = pk2(o[0], o[1]); wv.y = pk2(o[2], o[3]); wv.z = pk2(o[4], o[5]); wv.w = pk2(o[6], o[7]);
          *(u32x4*)(Y + (size_t)(t0 + row) * 1024 + 256 + n * 64 + cgp * 8) = wv; }
    }
    LBAR();
}

__device__ __forceinline__ void phase_mix(const Ctx p, int l, LAS unsigned char* lds) {
    LAS unsigned char* sm = lds;
    for (int cid = blockIdx.x; cid < 256; cid += gridDim.x) {
        const int mixer = cid & 3, w = cid >> 2, b = w >> 2, h = w & 3;
        if (mixer == 0) gla_chain<0>(p, l, b, h, sm);
        else if (mixer == 1) lru_chain(p, l, b, h, sm);
        else if (mixer == 2) gla_chain<2>(p, l, b, h, sm);
        else gla_chain<3>(p, l, b, h, sm);
    }
}


#define XB_TMO      128
#define XB_XCNT(j)  (256  + 64 * (j))
#define XB_XSUB(j)  (1280 + 64 * (j))
#define XB_XGEN(j)  (2304 + 64 * (j))
#define XB_TOP      3328
#define XB_TOPGEN   3392
#define XCD_BAR_WORDS 3456
#define XB_SPIN_CAP (1u << 22)
__device__ __forceinline__ unsigned xb_ld(unsigned* p)              { return __hip_atomic_load(p, __ATOMIC_RELAXED, __HIP_MEMORY_SCOPE_AGENT); }
__device__ __forceinline__ unsigned xb_add(unsigned* p, unsigned v) { return __hip_atomic_fetch_add(p, v, __ATOMIC_RELAXED, __HIP_MEMORY_SCOPE_AGENT); }
__device__ __forceinline__ unsigned xb_xcc_id() { return (unsigned)__builtin_amdgcn_s_getreg((3 << 11) | 20) & 0xFu; }
#define XB_SPIN(cond, bar) do { unsigned _sp = 0; while (cond) { __builtin_amdgcn_s_sleep(1); \
    if ((++_sp & 255u) == 0u) { if (xb_ld(&(bar)[XB_TMO])) break; if (_sp > XB_SPIN_CAP) { atomicAdd(&(bar)[XB_TMO], 1u); break; } } } } while (0)
struct XcdBarrier { unsigned* bar; unsigned x; volatile LAS unsigned* st; };
__device__ __forceinline__ XcdBarrier xcd_barrier_post(unsigned* bar, volatile LAS unsigned* st) {
    XcdBarrier b; b.bar = bar; b.x = xb_xcc_id(); b.st = st;
    if (threadIdx.x == 0) (void)xb_add(&bar[XB_XCNT(b.x)], 1u);
    return b;
}
__device__ __forceinline__ void xcd_barrier_complete(unsigned* bar, unsigned x, unsigned& nloc, unsigned& nx) {
    const unsigned G = gridDim.x * gridDim.y * gridDim.z;
    unsigned sum, cnt, mine, sp = 0u;
    for (;;) {
        sum = 0u; cnt = 0u; mine = 0u;
#pragma unroll
        for (unsigned j = 0; j < 16; ++j) { const unsigned c = xb_ld(&bar[XB_XCNT(j)]); sum += c; cnt += (c > 0u) ? 1u : 0u; mine = (j == x) ? c : mine; }
        if (sum == G) break;
        __builtin_amdgcn_s_sleep(1);
        if ((++sp & 255u) == 0u) { if (xb_ld(&bar[XB_TMO])) break; if (sp > XB_SPIN_CAP) { atomicAdd(&bar[XB_TMO], 1u); break; } }
    }
    nloc = mine > 0u ? mine : 1u; nx = cnt > 0u ? cnt : 1u;
}
__device__ __forceinline__ void xcd_barrier(const XcdBarrier& b) {
    asm volatile("s_waitcnt vmcnt(0)" ::: "memory");
    __syncthreads();
    if (threadIdx.x == 0) {
        unsigned* bar = b.bar;
        __builtin_amdgcn_s_waitcnt(0);
        unsigned nloc = b.st[0], nx = b.st[1];
        if (nloc == 0u) { xcd_barrier_complete(bar, b.x, nloc, nx); b.st[0] = nloc; b.st[1] = nx; }
        const unsigned old = xb_add(&bar[XB_XSUB(b.x)], 1u);
        const unsigned gen = old / nloc;
        if (old + 1u == (gen + 1u) * nloc) {
            __builtin_amdgcn_fence(__ATOMIC_RELEASE, "agent");
            asm volatile("s_waitcnt vmcnt(0)" ::: "memory");
            const unsigned og = xb_add(&bar[XB_TOP], 1u);
            const unsigned tg = og / nx;
            if (og + 1u == (tg + 1u) * nx) xb_add(&bar[XB_TOPGEN], 1u);
            else XB_SPIN(xb_ld(&bar[XB_TOPGEN]) == tg, bar);
            __builtin_amdgcn_fence(__ATOMIC_ACQUIRE, "agent");
            xb_add(&bar[XB_XGEN(b.x)], 1u);
            asm volatile("s_waitcnt vmcnt(0)" ::: "memory");
        } else {
            XB_SPIN(xb_ld(&bar[XB_XGEN(b.x)]) == gen, bar);
            __builtin_amdgcn_fence(__ATOMIC_ACQUIRE, "agent");
            asm volatile("s_waitcnt vmcnt(0)" ::: "memory");
        }
    }
    __syncthreads();
}

enum { T_PREP = 0, T_GBF, T_GSWI, T_GRES, T_MIX, T_SOFTMAX, T_FINAL };
constexpr int SPL = 12;
constexpr int NSTEPS = 2 + SPL * NL + 1;
__host__ __device__ __forceinline__ void decode_step(int st, int& type, int& l, int& sub, bool& sync) {
    sync = true; l = 0; sub = 0;
    if (st == 0) { type = T_PREP; return; }
    if (st == 1) { type = T_GBF; sub = 0; return; }
    if (st == NSTEPS - 1) { type = T_FINAL; return; }
    const int r = (st - 2) % SPL; l = (st - 2) / SPL;
    switch (r) {
        case 0: type = T_GSWI; sub = 0; break;
        case 1: type = T_GRES; sub = 0; break;
        case 2: type = T_GBF; sub = 1; break;
        case 3: type = T_MIX; break;
        case 4: type = T_GRES; sub = 1; sync = false; break;
        case 5: type = T_GBF; sub = 2; sync = false; break;
        case 6: type = T_GBF; sub = 3; break;
        case 7: type = T_GBF; sub = 4; break;
        case 8: type = T_SOFTMAX; break;
        case 9: type = T_GRES; sub = 2; break;
        case 10: type = T_GSWI; sub = 1; break;
        default: type = T_GRES; sub = 3; break;
    }
}

__global__ void __launch_bounds__(512, 2) fwd_kernel(Params pk) {
    extern __shared__ __attribute__((aligned(16))) unsigned char lds_raw[];
    LAS unsigned char* lds = (LAS unsigned char*)lds_raw;
    { const unsigned* ka = (const unsigned*)__builtin_amdgcn_kernarg_segment_ptr();
      if (threadIdx.x < sizeof(Params) / 4) ((LAS unsigned*)(lds + PARAM_OFF))[threadIdx.x] = ka[threadIdx.x];
      if (threadIdx.x < 2) ((LAS unsigned*)(lds + PARAM_OFF + 512))[threadIdx.x] = 0u; }
    __syncthreads();
    Ctx p; p.lds = lds;
#if MK_ONE_LAUNCH
    const XcdBarrier xbar = xcd_barrier_post((unsigned*)p.ws(), (volatile LAS unsigned*)(lds + PARAM_OFF + 512));
#endif
    const int G = gridDim.x, c = blockIdx.x;
    const int st_hi = p.hi();
    for (int st = p.lo(); st < st_hi; ++st) {
        unsigned char* ws = p.ws();
        int type, l, sub; bool sync;
        decode_step(st, type, l, sub, sync);
        const char* wl = (const char*)(ws + WS_W + (size_t)l * LAYER_W);
        if (type == T_PREP) { for (int rep = 0; rep < REP_PREP; ++rep) phase_prep(p, lds); phase_init(p); }
        else if (type == T_GBF) {
            pg8::Gemm g; pg8::Sched S; pg8::EpiBf16 E; S.G = G; S.c = c; S.bB = 0; E.sc = 1.0f; E.rsp = nullptr; S.nM = 1; S.nN = 1;
            if (sub == 0) { g = {(const char*)(ws + WS_MEMN), (const char*)(ws + WS_W + W_KV), 1024, 1024, 1024}; S.kind = 2; S.nwg = 512; S.tA = 256 * 1024 * 2; S.tB = 256 * 1024 * 2; S.ldc = 2048; S.cw = 256; E.O = (bf16_t*)(ws + WS_KV); E.ldc = 2048; }
            else if (sub == 1) { E.rsp = (const float*)(ws + WS_RSP); g = {(const char*)(ws + WS_XB), wl + W_IN, 1024, 1024, 1024}; S.kind = 0; S.nM = 256; S.nN = 14; S.nwg = 256 * 14; S.tA = 256 * 1024 * 2; S.tB = 256 * 1024 * 2; S.ldc = DINP; S.cw = 256; E.O = (bf16_t*)(ws + WS_PROJ); E.ldc = DINP; }
            else if (sub == 2) { g = {(const char*)(ws + WS_KV + (size_t)l * 4096 * 2048 * 2), wl + W_Q, 2048, 1024, 256}; S.kind = 3; S.nwg = 256; S.tA = 0; S.tB = 0; S.ldc = 1024; S.cw = 256; E.O = (bf16_t*)(ws + WS_XM); E.ldc = 1024; }
            else if (sub == 3) { g = {wl + W_O, (const char*)(ws + WS_KV + (size_t)l * 4096 * 2048 * 2), 1024, 2048, 256}; S.kind = 4; S.nwg = 256; S.tA = 0; S.tB = 0; S.ldc = 1024; S.cw = 256; E.O = (bf16_t*)(ws + WS_XN); E.ldc = 1024; }
            else { E.rsp = (const float*)(ws + WS_RSP); g = {(const char*)(ws + WS_XB), (const char*)(ws + WS_XM), 1024, 1024, 1024}; S.kind = 1; S.nM = 256; S.nN = 4; S.nwg = 1024; S.tA = 256 * 1024 * 2; S.tB = 256 * 1024 * 2; S.bB = (size_t)1024 * 1024 * 2; S.ldc = 1024; S.cw = 256; E.O = (bf16_t*)(ws + WS_PROJ); E.ldc = 1024; E.sc = 0.0625f; }
            pg8::gemm_phase<pg8::EpiBf16>(lds, g, S, E);
        } else if (type == T_GSWI) {
            pg8::Gemm g = {(const char*)(ws + WS_XB), wl + (sub == 0 ? W_GU1 : W_GU2), 1024, 1024, 1024};
            pg8::Sched S; S.kind = 0; S.nM = 256; S.nN = 22; S.nwg = 256 * 22; S.G = G; S.c = c; S.ldc = FF; S.cw = 128; S.tA = 256 * 1024 * 2; S.tB = 256 * 1024 * 2; S.bB = 0;
            pg8::EpiSwi E; E.O = (bf16_t*)(ws + WS_PROJ); E.ldc = FF; E.rsp = (const float*)(ws + WS_RSP);
            for (int rep = 0; rep < REP_GSWI; ++rep) pg8::gemm_phase<pg8::EpiSwi>(lds, g, S, E);
        } else if (type == T_GRES) {
            const bool dn = (sub == 0 || sub == 3);
            const int kk = dn ? FF : 1024;
            const char* ga = (const char*)(ws + (sub == 1 ? WS_Y : WS_PROJ));
            const char* gb = dn ? wl + (sub == 0 ? W_D1 : W_D2) : (sub == 1 ? wl + W_OUT : (const char*)(ws + WS_XN));
            const pg8::Gemm g = {ga, gb, kk, kk, kk};
            pg8::Sched S; S.kind = (sub == 2) ? 1 : 0; S.nM = 256; S.nN = 4; S.nwg = 1024; S.G = G; S.c = c; S.ldc = 1024; S.cw = 256; S.bB = (sub == 2) ? (size_t)1024 * 1024 * 2 : (size_t)0;
            S.tA = (size_t)256 * kk * 2; S.tB = (size_t)256 * kk * 2;
            const pg8::EpiRes E = {p.out(), dn ? 0.5f : 1.0f, (bf16_t*)(ws + WS_XB), (float*)(ws + WS_RSP)};
            pg8::gemm_phase<pg8::EpiRes>(lds, g, S, E);
        } else if (type == T_MIX) { for (int rep = 0; rep < REP_MIX; ++rep) phase_mix(p, l, lds); }
        else if (type == T_SOFTMAX) phase_softmax(p);
        else phase_final(p);
        #if MK_ONE_LAUNCH
        if (sync && st + 1 < st_hi) { for (int rep = 0; rep < REP_SYNC; ++rep) { if (st == 0) cg::this_grid().sync(); else xcd_barrier(xbar); } }
#else
        if (sync && st + 1 < st_hi) cg::this_grid().sync();
#endif
    }
}

extern "C" void kernel_launch(void* const* d_in, const int* in_sizes, int n_in, void* d_out, int out_size, void* d_ws, size_t ws_size, hipStream_t stream) {
    static int grid = 0;
    if (grid == 0) {
        if (n_in != 27 || out_size != TT * DM || ws_size < WS_END) { fprintf(stderr, "kernel_launch: unexpected shapes (n_in %d out %d ws %zu)\n", n_in, out_size, ws_size); grid = -1; return; }
        int dev = 0, cus = 0, per_cu = 0;
        hipGetDevice(&dev); hipDeviceGetAttribute(&cus, hipDeviceAttributeMultiprocessorCount, dev);
        hipFuncSetAttribute((const void*)fwd_kernel, hipFuncAttributeMaxDynamicSharedMemorySize, LDS_BYTES);
        hipOccupancyMaxActiveBlocksPerMultiprocessor(&per_cu, (const void*)fwd_kernel, 512, LDS_BYTES);
        if (per_cu < 1) per_cu = 1;
        grid = cus * per_cu;
        (void)hipGetLastError();
    }
    if (grid < 0) return;
    Params p{};
    for (int i = 0; i < 27; ++i) p.in[i] = (const float*)d_in[i];
    p.out = (float*)d_out; p.ws = (unsigned char*)d_ws;
    for (int d = 0; d < 32; ++d) p.inv_freq[d] = powf(10000.0f, -(float)d / 32.0f);
#if MK_ONE_LAUNCH
    (void)hipMemsetAsync(d_ws, 0, 65536, stream);
    p.lo = 0; p.hi = NSTEPS;
    void* args[] = {&p};
    hipError_t e = hipLaunchCooperativeKernel((const void*)fwd_kernel, dim3(grid), dim3(512), args, LDS_BYTES, stream);
    if (e != hipSuccess) fprintf(stderr, "cooperative launch failed: %s (grid %d)\n", hipGetErrorString(e), grid);
#else
    int lo = 0;
    for (int st = 0; st < NSTEPS; ++st) {
        int type, l, sub; bool sync; decode_step(st, type, l, sub, sync);
        if (sync || st == NSTEPS - 1) { p.lo = lo; p.hi = st + 1; hipLaunchKernelGGL(fwd_kernel, dim3(grid), dim3(512), LDS_BYTES, stream, p); lo = st + 1; }
    }
#endif
}
```
